# Optimizing an MI355X kernel written in HIP

```python
import math
import jax, jax.numpy as jnp
from jax import lax
import numpy as np

D_MODEL = 1024
BATCH = 2
SEQ = 16384
DEPTH = 1

D_MIX = D_MODEL
HGRN_WIDTH = (3 * D_MIX) // 4
HGRN_DK = 128
HGRN_HEADS = HGRN_WIDTH // HGRN_DK
HGRN_DV = HGRN_WIDTH // HGRN_HEADS
HGRN_CHUNK = 64
ATTN_WIDTH = D_MIX - HGRN_WIDTH
ATTN_HEAD_DIM = 64
ATTN_HEADS = ATTN_WIDTH // ATTN_HEAD_DIM
ROT_DIM = ATTN_HEAD_DIM // 4
ROPE_THETA = 500000.0
MOBA_BLOCK = 256
MOBA_TOPK = 3
Q_BLOCK = 128
N_EXPERTS = 32
TOP_K = 4
D_FF = D_MODEL
SWIGLU_ALPHA = 1.702
SWIGLU_LIMIT = 7.0
MOE_BLOCK = 256
N_MOD = 6
RMS_EPS = 1e-6
D_PROJ = 4 * HGRN_WIDTH + 3 * ATTN_WIDTH

kernel_name = "hymba_hgrn2_moba_moe_block"


def rms_norm(x, g, eps=RMS_EPS):
    xf = x.astype(jnp.float32)
    y = xf * lax.rsqrt(jnp.mean(xf * xf, axis=-1, keepdims=True) + eps)
    return (y * g.astype(jnp.float32)).astype(x.dtype)


def split_heads(t, n_heads):
    B, S, W = t.shape
    return t.reshape(B, S, n_heads, W // n_heads).transpose(0, 2, 1, 3)


def merge_heads(t):
    B, H, S, d = t.shape
    return t.transpose(0, 2, 1, 3).reshape(B, S, H * d)


def partial_rotary(t, cos, sin):
    half = ROT_DIM // 2
    t1 = t[..., :half].astype(jnp.float32)
    t2 = t[..., half:ROT_DIM].astype(jnp.float32)
    rot = jnp.concatenate([t1 * cos - t2 * sin, t2 * cos + t1 * sin], axis=-1).astype(t.dtype)
    return jnp.concatenate([rot, t[..., ROT_DIM:]], axis=-1)


def hgrn2_recurrence(q, k, v, log_f):
    B, H, S, dk = q.shape
    dv = v.shape[-1]
    n_chunks = S // HGRN_CHUNK

    def chunked(t):
        return jnp.moveaxis(t.reshape(B, H, n_chunks, HGRN_CHUNK, t.shape[-1]), 2, 0)

    qc, kc, vc = chunked(q), chunked(k), chunked(v)
    bc = jnp.cumsum(chunked(log_f), axis=3)
    causal = jnp.tril(jnp.ones((HGRN_CHUNK, HGRN_CHUNK), dtype=bool))[:, :, None]

    def step(state, inp):
        q_c, k_c, v_c, b_c = inp
        b_last = b_c[:, :, -1:, :]
        o_inter = jnp.einsum('bhtk,bhkv->bhtv', q_c * jnp.exp(b_c), state)
        diff = b_c[:, :, :, None, :] - b_c[:, :, None, :, :]
        decay = jnp.exp(jnp.where(causal, diff, -jnp.inf))
        scores = jnp.einsum('bhtk,bhtsk,bhsk->bhts', q_c, decay, k_c)
        o_intra = jnp.einsum('bhts,bhsv->bhtv', scores, v_c)
        new_state = (jnp.exp(b_last[:, :, 0, :])[..., None] * state
                     + jnp.einsum('bhsk,bhsv->bhkv', k_c * jnp.exp(b_last - b_c), v_c))
        return new_state, o_inter + o_intra

    state0 = jnp.zeros((B, H, dk, dv), jnp.float32)
    _, o = lax.scan(step, state0, (qc, kc, vc, bc))
    return jnp.moveaxis(o, 0, 2).reshape(B, H, S, dv)


def moba_attention(q, k, v):
    B, H, S, hd = q.shape
    n_blocks = -(-S // MOBA_BLOCK)
    pad = n_blocks * MOBA_BLOCK - S
    kb = jnp.pad(k, ((0, 0), (0, 0), (0, pad), (0, 0))).reshape(B, H, n_blocks, MOBA_BLOCK, hd)
    vb = jnp.pad(v, ((0, 0), (0, 0), (0, pad), (0, 0))).reshape(B, H, n_blocks, MOBA_BLOCK, hd)
    k_mean = jnp.mean(kb.astype(jnp.float32), axis=3)
    topk = min(MOBA_TOPK, n_blocks)
    n_q = S // Q_BLOCK
    q_blocks = jnp.moveaxis(q.reshape(B, H, n_q, Q_BLOCK, hd), 2, 0)
    b_idx = jnp.arange(B)[:, None, None, None]
    h_idx = jnp.arange(H)[None, :, None, None]
    scale = hd ** -0.5

    def one_block(args):
        qb, n = args
        q_pos = n * Q_BLOCK + jnp.arange(Q_BLOCK)
        own = (n * Q_BLOCK) // MOBA_BLOCK
        gate = jnp.einsum('bhqd,bhnd->bhqn', qb.astype(jnp.float32), k_mean)
        gate = jnp.where(jnp.arange(n_blocks) < own, gate, -jnp.inf)
        _, sel = lax.top_k(gate, topk)
        valid = jnp.arange(topk) < own
        k_sel = kb[b_idx, h_idx, sel]
        v_sel = vb[b_idx, h_idx, sel]
        s_sel = jnp.einsum('bhqd,bhqnkd->bhqnk', qb, k_sel).astype(jnp.float32) * scale
        s_sel = jnp.where(valid[:, None], s_sel, -jnp.inf).reshape(B, H, Q_BLOCK, topk * MOBA_BLOCK)
        k_own = lax.dynamic_index_in_dim(kb, own, axis=2, keepdims=False)
        v_own = lax.dynamic_index_in_dim(vb, own, axis=2, keepdims=False)
        k_pos = own * MOBA_BLOCK + jnp.arange(MOBA_BLOCK)
        s_own = jnp.einsum('bhqd,bhkd->bhqk', qb, k_own).astype(jnp.float32) * scale
        s_own = jnp.where(k_pos[None, :] <= q_pos[:, None], s_own, -jnp.inf)
        p = jax.nn.softmax(jnp.concatenate([s_sel, s_own], axis=-1), axis=-1).astype(q.dtype)
        p_sel = p[..., :topk * MOBA_BLOCK].reshape(B, H, Q_BLOCK, topk, MOBA_BLOCK)
        p_own = p[..., topk * MOBA_BLOCK:]
        return (jnp.einsum('bhqnk,bhqnkd->bhqd', p_sel, v_sel)
                + jnp.einsum('bhqk,bhkd->bhqd', p_own, v_own))

    out = lax.map(one_block, (q_blocks, jnp.arange(n_q)))
    return jnp.moveaxis(out, 0, 2).reshape(B, H, S, hd)


def moe_ffn(h, w_router, b_router, w_gate_up, b_gate_up, w_down, b_down):
    T, D = h.shape
    n_assign = T * TOP_K
    logits = (h @ w_router + b_router).astype(jnp.float32)
    top_val, top_idx = lax.top_k(logits, TOP_K)
    gates = jax.nn.softmax(top_val, axis=-1).astype(h.dtype)
    flat_e = top_idx.reshape(-1)
    flat_tok = jnp.arange(n_assign, dtype=jnp.int32) // TOP_K
    order = jnp.argsort(flat_e)
    sorted_e = flat_e[order]
    sorted_tok = flat_tok[order]
    sorted_gate = gates.reshape(-1)[order]
    counts = jax.ops.segment_sum(jnp.ones_like(flat_e), flat_e, num_segments=N_EXPERTS)
    group_start = jnp.cumsum(counts) - counts
    padded = (counts + MOE_BLOCK - 1) // MOE_BLOCK * MOE_BLOCK
    pad_end = jnp.cumsum(padded)
    pad_start = pad_end - padded
    dest = pad_start[sorted_e] + jnp.arange(n_assign, dtype=jnp.int32) - group_start[sorted_e]
    n_blk = -(-n_assign // MOE_BLOCK) + N_EXPERTS
    tok_buf = jnp.full((n_blk * MOE_BLOCK,), T, jnp.int32).at[dest].set(sorted_tok)
    gate_buf = jnp.zeros((n_blk * MOE_BLOCK,), h.dtype).at[dest].set(sorted_gate)
    blk_expert = jnp.minimum(
        jnp.searchsorted(pad_end, jnp.arange(n_blk, dtype=jnp.int32) * MOE_BLOCK, side='right'),
        N_EXPERTS - 1)
    h_pad = jnp.concatenate([h, jnp.zeros((1, D), h.dtype)], axis=0)

    def expert_block(args):
        toks, g, e = args
        xb = h_pad[toks]
        gu = xb @ w_gate_up[e] + b_gate_up[e]
        gate = jnp.minimum(gu[:, :D_FF], SWIGLU_LIMIT)
        up = jnp.clip(gu[:, D_FF:], -SWIGLU_LIMIT, SWIGLU_LIMIT)
        act = (up + 1.0) * gate * jax.nn.sigmoid(SWIGLU_ALPHA * gate)
        return (act @ w_down[e] + b_down[e]) * g[:, None]

    y = lax.map(expert_block, (tok_buf.reshape(n_blk, MOE_BLOCK),
                               gate_buf.reshape(n_blk, MOE_BLOCK), blk_expert))
    return jax.ops.segment_sum(y.reshape(-1, D), tok_buf, num_segments=T + 1)[:T]


def setup_inputs(seed: int = 0) -> dict:
    key = jax.random.key(seed)
    ks = jax.random.split(key, 20)
    f32 = jnp.float32
    nrm = lambda k, shape, s: jax.random.normal(k, shape, f32) * s
    x = jax.random.normal(ks[0], (BATCH, SEQ, D_MODEL), f32)
    c = jax.random.normal(ks[1], (BATCH, D_MODEL), f32)
    offset = jax.random.randint(ks[2], (BATCH, 1), 0, 4096, dtype=jnp.int32)
    positions = offset + jnp.arange(SEQ, dtype=jnp.int32)[None, :]
    return {
        "x": x,
        "c": c,
        "positions": positions,
        "w_ada": nrm(ks[3], (DEPTH, D_MODEL, N_MOD * D_MODEL), 0.5 * D_MODEL ** -0.5),
        "b_ada": nrm(ks[4], (DEPTH, N_MOD * D_MODEL), 0.02),
        "norm1_g": 1.0 + nrm(ks[5], (DEPTH, D_MODEL), 0.02),
        "w_in": nrm(ks[6], (DEPTH, D_MODEL, D_PROJ), D_MODEL ** -0.5),
        "hgrn_lb_logits": nrm(ks[7], (DEPTH + 1, HGRN_WIDTH), 0.5),
        "hgrn_norm_g": 1.0 + nrm(ks[8], (DEPTH, HGRN_DV), 0.02),
        "attn_norm_g": 1.0 + nrm(ks[9], (DEPTH, ATTN_HEAD_DIM), 0.02),
        "w_out": nrm(ks[10], (DEPTH, D_MIX, D_MODEL), D_MIX ** -0.5),
        "norm2_g": 1.0 + nrm(ks[11], (DEPTH, D_MODEL), 0.02),
        "w_router": nrm(ks[12], (DEPTH, D_MODEL, N_EXPERTS), D_MODEL ** -0.5),
        "b_router": nrm(ks[13], (DEPTH, N_EXPERTS), 0.01),
        "w_gate_up": nrm(ks[14], (DEPTH, N_EXPERTS, D_MODEL, 2 * D_FF), D_MODEL ** -0.5),
        "b_gate_up": nrm(ks[15], (DEPTH, N_EXPERTS, 2 * D_FF), 0.02),
        "w_down": nrm(ks[16], (DEPTH, N_EXPERTS, D_FF, D_MODEL), D_FF ** -0.5),
        "b_down": nrm(ks[17], (DEPTH, N_EXPERTS, D_MODEL), 0.02),
        "final_norm_g": 1.0 + nrm(ks[18], (D_MODEL,), 0.02),
    }


def reference(x, c, positions, w_ada, b_ada, norm1_g, w_in, hgrn_lb_logits, hgrn_norm_g,
              attn_norm_g, w_out, norm2_g, w_router, b_router, w_gate_up, b_gate_up,
              w_down, b_down, final_norm_g):
    B, S, D = x.shape
    inv_freq = jnp.exp(-math.log(ROPE_THETA) * jnp.arange(0, ROT_DIM, 2, dtype=jnp.float32) / ROT_DIM)
    ang = positions.astype(jnp.float32)[:, None, :, None] * inv_freq
    cos, sin = jnp.cos(ang), jnp.sin(ang)
    lower_bounds = jnp.cumsum(jax.nn.softmax(hgrn_lb_logits.astype(jnp.float32), axis=0), axis=0)
    splits = [HGRN_WIDTH, 2 * HGRN_WIDTH, 3 * HGRN_WIDTH, 4 * HGRN_WIDTH,
              4 * HGRN_WIDTH + ATTN_WIDTH, 4 * HGRN_WIDTH + 2 * ATTN_WIDTH]
    for l in range(DEPTH):
        mod = jax.nn.silu(c) @ w_ada[l] + b_ada[l]
        shift1, scale1, gate1, shift2, scale2, gate2 = jnp.split(mod[:, None, :], N_MOD, axis=-1)

        h = rms_norm(x, norm1_g[l]) * (1.0 + scale1) + shift1
        proj = h @ w_in[l]
        hq, hf, hi, hg, aq, ak, av = jnp.split(proj, splits, axis=-1)

        lb = lower_bounds[l]
        f = lb + (1.0 - lb) * jax.nn.sigmoid(hf.astype(jnp.float32))
        q_h = split_heads(jax.nn.silu(hq.astype(jnp.float32)) * HGRN_DK ** -0.5, HGRN_HEADS)
        k_h = split_heads(1.0 - f, HGRN_HEADS)
        v_h = split_heads(hi.astype(jnp.float32), HGRN_HEADS)
        o_h = hgrn2_recurrence(q_h, k_h, v_h, split_heads(jnp.log(f), HGRN_HEADS)).astype(x.dtype)
        o_h = rms_norm(o_h, hgrn_norm_g[l]) * jax.nn.silu(split_heads(hg, HGRN_HEADS))

        q_a = partial_rotary(split_heads(aq, ATTN_HEADS), cos, sin)
        k_a = partial_rotary(split_heads(ak, ATTN_HEADS), cos, sin)
        v_a = split_heads(av, ATTN_HEADS)
        o_a = rms_norm(moba_attention(q_a, k_a, v_a), attn_norm_g[l])

        mix = jnp.concatenate([merge_heads(o_h), merge_heads(o_a)], axis=-1) @ w_out[l]
        x = x + gate1 * mix

        h2 = rms_norm(x, norm2_g[l]) * (1.0 + scale2) + shift2
        y = moe_ffn(h2.reshape(B * S, D), w_router[l], b_router[l], w_gate_up[l],
                    b_gate_up[l], w_down[l], b_down[l]).reshape(B, S, D)
        x = x + gate2 * y
    return rms_norm(x, final_norm_g)
```

```cpp
#include <hip/hip_runtime.h>
#include <hip/hip_cooperative_groups.h>
#include <cstdio>
#include <cstdint>
namespace cg = cooperative_groups;

#ifndef MEGA
#define MEGA 1
#endif
#ifndef PROBE_EPI
#define PROBE_EPI 0
#endif
#ifndef PROBEX
#define PROBEX 0
#endif
#ifndef PROBE4
#define PROBE4 0
#endif
#ifndef PROBE_DUP
#define PROBE_DUP 0
#endif
#ifndef FAST0
#define FAST0 1
#endif
#ifndef FAST6
#define FAST6 1
#endif
#ifndef XBAR
#define XBAR 1
#endif
#ifndef MOE_FP8
#define MOE_FP8 1
#endif
#ifndef INPROJ_FP8
#define INPROJ_FP8 1
#endif
#ifndef P3B_WS
#define P3B_WS 1
#endif
#ifndef HG_V2
#define HG_V2 1
#endif
#ifndef HG_FAST
#define HG_FAST 1
#endif
#ifndef MB_FAST
#define MB_FAST 1
#endif
#ifndef FAST2
#define FAST2 1
#endif
#ifndef FAST5
#define FAST5 1
#endif
#ifndef FAST7
#define FAST7 1
#endif
#ifndef FAST8
#define FAST8 1
#endif

typedef unsigned short bf16_t;
typedef short bf16x8 __attribute__((ext_vector_type(8)));
typedef float f32x4 __attribute__((ext_vector_type(4)));
typedef unsigned u32x4 __attribute__((ext_vector_type(4)));
typedef unsigned u32x2 __attribute__((ext_vector_type(2)));
#define LAS __attribute__((address_space(3)))

constexpr int NB_ = 2, S_ = 16384, T_ = NB_ * S_, D_ = 1024;
constexpr int HW_ = 768, NPROJ = 3840, NHH = 6, DK_ = 128;
constexpr int AHN = 4, HD_ = 64;
constexpr int NE_ = 32, DFF_ = 1024, TOPK_ = 4;
constexpr int NMOD = 6 * D_;
constexpr int NTHREADS = 512, NWAVES = 8;
constexpr float RMS_EPS = 1e-6f;
constexpr int C_HQ = 0, C_HF = 768, C_HI = 1536, C_HG = 2304, C_AQ = 3072, C_AK = 3328, C_AV = 3584;

constexpr size_t KB = 1024, MBy = 1024 * 1024;
constexpr size_t OFF_CTL = 0;
constexpr size_t OFF_MOD = 64 * KB;
constexpr size_t OFF_CS = 128 * KB;
constexpr size_t OFF_WRT = OFF_CS + (size_t)T_ * 16 * 4;
constexpr size_t OFF_LB = OFF_WRT + 32 * 1024 * 4;
constexpr size_t OFF_KM = OFF_LB + 4096;
constexpr size_t OFF_GATE = OFF_KM + 8 * 64 * 64 * 4;
constexpr size_t OFF_ELIST = OFF_GATE + (size_t)T_ * 4 * 4;
constexpr size_t OFF_WIN = OFF_ELIST + (size_t)32 * 32768 * 4;
constexpr size_t OFF_WOUT = OFF_WIN + (size_t)NPROJ * D_ * 2;
constexpr size_t OFF_WGU = OFF_WOUT + (size_t)D_ * D_ * 2;
constexpr size_t OFF_WDN = OFF_WGU + (size_t)NE_ * 2048 * 1024 * 2;
constexpr size_t OFF_H = OFF_WDN + (size_t)NE_ * 1024 * 1024 * 2;
constexpr size_t OFF_OP = OFF_H + (size_t)T_ * D_ * 2;
constexpr size_t OFF_MIX = OFF_OP + (size_t)T_ * D_ * 2;
constexpr size_t OFF_X = OFF_MIX + (size_t)T_ * D_ * 2;
constexpr size_t OFF_OUT2 = OFF_H;
constexpr size_t OFF_WIN8 = OFF_X + 32 * MBy;
constexpr size_t OFF_H8 = OFF_OP;
constexpr size_t OFF_X1B = OFF_X;
constexpr float OUT2_SCALE = 16.f, OUT2_INV = 1.f / 16.f;
constexpr size_t OFF_PROJ = OFF_X + (size_t)T_ * D_ * 2;
constexpr size_t OFF_U = OFF_PROJ + (size_t)T_ * NPROJ * 2;
constexpr size_t OFF_ACT = OFF_PROJ;
constexpr size_t OFF_DEC = OFF_U + (size_t)T_ * HW_ * 4;
constexpr size_t WS_END = OFF_DEC + 2 * MBy;
constexpr int CW_ECNT = 512;
constexpr int CW_BAR = 4096;

struct Params {
    const float *x, *c; const int* pos;
    const float *w_ada, *b_ada, *norm1_g, *w_in, *lb_logits, *hgrn_norm_g, *attn_norm_g, *w_out, *norm2_g, *w_router, *b_router,
        *w_gu, *b_gu, *w_dn, *b_dn, *final_g;
    float* out; unsigned char* ws;
};

__device__ __forceinline__ int tidx() { int t = threadIdx.x; asm volatile("" : "+v"(t)); return t; }
__device__ __forceinline__ float bf2f(bf16_t v) { return __uint_as_float(((unsigned)v) << 16); }
__device__ __forceinline__ bf16_t f2bf(float f) { unsigned u = __float_as_uint(f); u += 0x7FFFu + ((u >> 16) & 1u); return (bf16_t)(u >> 16); }
typedef __bf16 bf16v2_t __attribute__((ext_vector_type(2)));
__device__ __forceinline__ unsigned pk2(float lo, float hi) { bf16v2_t v = {(__bf16)lo, (__bf16)hi}; return __builtin_bit_cast(unsigned, v); }
__device__ __forceinline__ unsigned pk4_fp8(float a, float b, float c, float d) {
    int r = __builtin_amdgcn_cvt_pk_fp8_f32(a, b, 0, false);
    r = __builtin_amdgcn_cvt_pk_fp8_f32(c, d, r, true);
    return (unsigned)r;
}
constexpr float W8_SCALE = 32.f, W8_INV = 1.f / 32.f;
__device__ __forceinline__ float wave_sum(float v) {
#pragma unroll
    for (int o = 1; o < 64; o <<= 1) v += __shfl_xor(v, o);
    return v;
}
__device__ __forceinline__ float sigmoidf_(float v) { return __builtin_amdgcn_rcpf(1.f + __expf(-v)); }
__device__ __forceinline__ float siluf_(float v) { return v * __builtin_amdgcn_rcpf(1.f + __expf(-v)); }

__device__ __forceinline__ void transpose_tile(const float* W, int K, int N, bf16_t* WT, int tile, LAS float* sm) {
    const int tid = tidx();
    const int ntn = N / 64, kb = tile / ntn, nb = tile % ntn, k0 = kb * 64, n0 = nb * 64;
    {
        const int n = tid & 63, kr = tid >> 6;
#pragma unroll
        for (int i = 0; i < 8; ++i) { const int k = kr + 8 * i; sm[k * 65 + n] = W[(size_t)(k0 + k) * N + n0 + n]; }
    }
    __syncthreads();
    {
        const int n = tid >> 3, kg = tid & 7;
        u32x4 o;
        o.x = pk2(sm[(8 * kg + 0) * 65 + n], sm[(8 * kg + 1) * 65 + n]);
        o.y = pk2(sm[(8 * kg + 2) * 65 + n], sm[(8 * kg + 3) * 65 + n]);
        o.z = pk2(sm[(8 * kg + 4) * 65 + n], sm[(8 * kg + 5) * 65 + n]);
        o.w = pk2(sm[(8 * kg + 6) * 65 + n], sm[(8 * kg + 7) * 65 + n]);
        *(u32x4*)(WT + (size_t)(n0 + n) * K + k0 + 8 * kg) = o;
    }
    __syncthreads();
}

__device__ __forceinline__ void phase0(const Params& p, int bid, int nb, LAS unsigned char* lds) {
    const int tid = tidx();
    float* mod = (float*)(p.ws + OFF_MOD);
    for (int j = bid * NTHREADS + tid; j < NMOD; j += nb * NTHREADS) {
        float a0 = 0.f, a1 = 0.f;
        for (int k = 0; k < D_; ++k) {
            const float w = p.w_ada[(size_t)k * NMOD + j];
            a0 += siluf_(p.c[k]) * w; a1 += siluf_(p.c[D_ + k]) * w;
        }
        mod[j] = a0 + p.b_ada[j]; mod[NMOD + j] = a1 + p.b_ada[j];
    }
    float* cs = (float*)(p.ws + OFF_CS);
    for (int i = bid * NTHREADS + tid; i < T_ * 8; i += nb * NTHREADS) {
        const int t = i >> 3, f = i & 7;
        float a = (float)(-13.122363377404328) * (float)(2 * f); a = a / 16.0f;
        const float invf = expf(a);
        const float ang = (float)p.pos[t] * invf;
        cs[t * 16 + f] = cosf(ang); cs[t * 16 + 8 + f] = sinf(ang);
    }
    float* wrt = (float*)(p.ws + OFF_WRT);
    for (int i = bid * NTHREADS + tid; i < 32 * 1024; i += nb * NTHREADS) { const int e = i >> 10, k = i & 1023; wrt[i] = p.w_router[k * 32 + e]; }
    { float* lbt = (float*)(p.ws + OFF_LB); for (int j = bid * NTHREADS + tid; j < HW_; j += nb * NTHREADS) lbt[j] = 1.f / (1.f + expf(p.lb_logits[HW_ + j] - p.lb_logits[j])); }
    LAS float* sm = (LAS float*)lds;
    constexpr int T_IN = (D_ / 64) * (NPROJ / 64), T_OUT = 16 * 16, T_GU = 16 * 32, T_DN = 16 * 16;
    constexpr int TOTAL = T_IN + T_OUT + NE_ * T_GU + NE_ * T_DN;
    for (int it = bid; it < TOTAL; it += nb) {
        int r = it;
        if (r < T_IN) { transpose_tile(p.w_in, D_, NPROJ, (bf16_t*)(p.ws + OFF_WIN), r, sm); continue; } r -= T_IN;
        if (r < T_OUT) { transpose_tile(p.w_out, D_, D_, (bf16_t*)(p.ws + OFF_WOUT), r, sm); continue; } r -= T_OUT;
        if (r < NE_ * T_GU) { const int e = r / T_GU; transpose_tile(p.w_gu + (size_t)e * 1024 * 2048, D_, 2048, (bf16_t*)(p.ws + OFF_WGU) + (size_t)e * 2048 * 1024, r % T_GU, sm); continue; } r -= NE_ * T_GU;
        { const int e = r / T_DN; transpose_tile(p.w_dn + (size_t)e * 1024 * 1024, DFF_, D_, (bf16_t*)(p.ws + OFF_WDN) + (size_t)e * 1024 * 1024, r % T_DN, sm); }
    }
}

__device__ __forceinline__ void phase1(const Params& p, int bid, int nb) {
    const int lane = tidx() & 63, wave = tidx() >> 6;
    const float* mod = (const float*)(p.ws + OFF_MOD);
    bf16_t* H = (bf16_t*)(p.ws + OFF_H);
    for (int t = bid * NWAVES + wave; t < T_; t += nb * NWAVES) {
        const int b = t / S_;
        const f32x4* xr = (const f32x4*)(p.x + (size_t)t * D_) + lane;
        f32x4 v[4]; float s = 0.f;
#pragma unroll
        for (int j = 0; j < 4; ++j) { v[j] = xr[64 * j]; s += v[j].x * v[j].x + v[j].y * v[j].y + v[j].z * v[j].z + v[j].w * v[j].w; }
        const float rstd = rsqrtf(wave_sum(s) * (1.f / D_) + RMS_EPS);
        const float* shift = mod + b * NMOD, *scale = mod + b * NMOD + D_;
#pragma unroll
        for (int j = 0; j < 4; ++j) {
            const int k = 4 * lane + 256 * j;
            const f32x4 g = *(const f32x4*)(p.norm1_g + k), sc = *(const f32x4*)(scale + k), sh = *(const f32x4*)(shift + k);
            const float o0 = v[j].x * rstd * g.x * (1.f + sc.x) + sh.x, o1 = v[j].y * rstd * g.y * (1.f + sc.y) + sh.y;
            const float o2 = v[j].z * rstd * g.z * (1.f + sc.z) + sh.z, o3 = v[j].w * rstd * g.w * (1.f + sc.w) + sh.w;
            uint2 w; w.x = pk2(o0, o1); w.y = pk2(o2, o3);
            *(uint2*)(H + (size_t)t * D_ + k) = w;
        }
    }
}

template <int NT>
__device__ __forceinline__ void wave_gemm(const bf16_t* arow, const bf16_t* const (&bcol)[NT], int K, f32x4 (&acc)[NT]) {
    const int g = (tidx() & 63) >> 4;
#pragma unroll
    for (int n = 0; n < NT; ++n) acc[n] = (f32x4){0.f, 0.f, 0.f, 0.f};
    for (int k0 = 0; k0 < K; k0 += 32) {
        const bf16x8 a = *(const bf16x8*)(arow + k0 + 8 * g);
#pragma unroll
        for (int n = 0; n < NT; ++n) {
            const bf16x8 b = *(const bf16x8*)(bcol[n] + k0 + 8 * g);
            acc[n] = __builtin_amdgcn_mfma_f32_16x16x32_bf16(a, b, acc[n], 0, 0, 0);
        }
    }
}


namespace pg8 {
constexpr int BM = 256, BK = 64, HALF = 128, HTB = HALF * BK * 2, STAGE_BYTES = 8 * HTB, NXCD = 8, WGM = 8;
constexpr int KD = 1024, NKT = KD / BK;
__device__ __forceinline__ int lds_byte(int r, int c) { const int st = (r >> 4) * 2 + (c >> 5), rr = r & 15, cc = c & 31, ob = rr * 64 + cc * 2; return st * 1024 + (ob ^ (((ob >> 9) & 1) << 5)); }
__device__ __forceinline__ void stage_rc(int b, int& R, int& C) { const int st = b / 1024, sb = b % 1024, swz = sb ^ (((sb >> 9) & 1) << 5); R = (st >> 1) * 16 + swz / 64; C = (st & 1) * 32 + (swz % 64) / 2; }
__device__ __forceinline__ int perm32(int rho) { const int n = rho >> 4, i = rho & 15; return 8 * (i >> 2) + 4 * n + (i & 3); }
struct Unit { int e, pm, pn, ui; };
__device__ __forceinline__ unsigned cvt_pk_bf16(float lo, float hi) { return pk2(lo, hi); }

__device__ __forceinline__ bool static_map(long L, int nM, int nN, Unit& u);
__device__ __forceinline__ bool static_next(int i, int G, int c, int nM, int nN, Unit& u) { const bool ok = static_map((long)i * G + c, nM, nN, u); u.ui = i; return ok; }
__device__ __forceinline__ bool static_map(long L, int nM, int nN, Unit& u) {
    const int nwg = nM * nN; if (L >= nwg) return false;
    int wgid = (int)L; { const int q = nwg / NXCD, r = nwg % NXCD, xcd = wgid % NXCD, off = wgid / NXCD; wgid = (xcd < r ? xcd * (q + 1) : r * (q + 1) + (xcd - r) * q) + off; }
    const int nig = WGM * nN, gid = wgid / nig, fm = gid * WGM, gsz = (nM - fm) < WGM ? (nM - fm) : WGM;
    u.pm = fm + ((wgid % nig) % gsz); u.pn = (wgid % nig) / gsz; u.e = 0; u.ui = 0; return true;
}

template <class Prob>
__device__ __forceinline__ void gemm_phase(LAS unsigned char* lds, const Prob& P) {
    const int tid = tidx(), wid = __builtin_amdgcn_readfirstlane(tid >> 6), lane = tid & 63, wr = wid >> 2, wc = wid & 3, fr = lane & 15, fq = lane >> 4;
    int R[2], Cc[2]; unsigned voffB[2];
#pragma unroll
    for (int i = 0; i < 2; ++i) { stage_rc(tid * 16 + i * 8192, R[i], Cc[i]); const int Rb = Prob::PERM ? ((R[i] & ~31) + perm32(R[i] & 31)) : R[i]; voffB[i] = (unsigned)(Rb * KD + Cc[i]) * 2u; }
    const unsigned ldsw = (unsigned)wid * 1024u;
    const int aoff = lds_byte(wr * 64 + fr, fq * 8), boff = lds_byte(wc * 32 + fr, fq * 8);
#define PG8_SA(b, h) (((b) * 2 + (h)) * HTB)
#define PG8_SB(b, h) ((4 + (b) * 2 + (h)) * HTB)
#define PG8_STAGE_B(bufoff, gbase) do { _Pragma("unroll") for (int _i = 0; _i < 2; ++_i) \
        __builtin_amdgcn_global_load_lds((const unsigned*)((const char*)(gbase) + voffB[_i]), (LAS unsigned*)(lds + (bufoff) + ldsw + _i * 8192), 16, 0, 0); } while (0)
#define PG8_STAGE_A(bufoff, o, kb) do { _Pragma("unroll") for (int _i = 0; _i < 2; ++_i) \
        __builtin_amdgcn_global_load_lds((const unsigned*)(Ab + ((o)[_i] + (unsigned)(kb))), (LAS unsigned*)(lds + (bufoff) + ldsw + _i * 8192), 16, 0, 0); } while (0)
#define PG8_LDA(dst, b, h) do { _Pragma("unroll") for (int m = 0; m < 4; ++m) _Pragma("unroll") for (int k = 0; k < 2; ++k) dst[m][k] = *(const LAS bf16x8*)(lds + PG8_SA(b, h) + aoff + m * 2048 + k * 1024); } while (0)
#define PG8_LDB(dst, b, h) do { _Pragma("unroll") for (int n = 0; n < 2; ++n) _Pragma("unroll") for (int k = 0; k < 2; ++k) dst[n][k] = *(const LAS bf16x8*)(lds + PG8_SB(b, h) + boff + n * 2048 + k * 1024); } while (0)
#define PG8_MMA(ai, bj, At, Bt) do { __builtin_amdgcn_s_setprio(1); _Pragma("unroll") for (int m = 0; m < 4; ++m) _Pragma("unroll") for (int n = 0; n < 2; ++n) _Pragma("unroll") for (int k = 0; k < 2; ++k) \
        acc[ai][bj][m][n] = __builtin_amdgcn_mfma_f32_16x16x32_bf16(Bt[n][k], At[m][k], acc[ai][bj][m][n], 0, 0, 0); __builtin_amdgcn_s_setprio(0); } while (0)
#define PG8_WAIT_V(n) asm volatile("s_waitcnt vmcnt(" #n ")" ::: "memory")
#define PG8_WAIT_L(n) asm volatile("s_waitcnt lgkmcnt(" #n ")" ::: "memory")
#define PG8_BAR __builtin_amdgcn_s_barrier()
#define PG8_SCHED __builtin_amdgcn_sched_barrier(0)
    Unit cur, nxt; int ui = 0;
    if (!P.next(0, cur)) return;
    f32x4 acc[2][2][4][2];
#pragma unroll
    for (int a = 0; a < 2; ++a)
#pragma unroll
        for (int b = 0; b < 2; ++b)
#pragma unroll
            for (int m = 0; m < 4; ++m)
#pragma unroll
                for (int n = 0; n < 2; ++n) acc[a][b][m][n] = (f32x4){0.f, 0.f, 0.f, 0.f};
    bf16x8 At[4][2], B0[2][2], B1[2][2];
    const char* Ab = P.a_base();
    const size_t bh = P.b_hstep();
    unsigned aoc[2][2], aon[2][2];
    P.a_off(cur, R, Cc, aoc);
    const char* cB = P.b_base(cur);
    PG8_STAGE_B(PG8_SB(0, 0), cB); PG8_STAGE_B(PG8_SB(0, 1), cB + bh); PG8_STAGE_A(PG8_SA(0, 0), aoc[0], 0); PG8_STAGE_A(PG8_SA(0, 1), aoc[1], 0);
    if (wr == 1) PG8_BAR;
    PG8_WAIT_V(2); PG8_BAR;
    PG8_STAGE_B(PG8_SB(1, 0), cB + BK * 2); PG8_STAGE_A(PG8_SA(1, 0), aoc[0], BK * 2); PG8_STAGE_B(PG8_SB(1, 1), cB + bh + BK * 2);
    PG8_WAIT_V(6); PG8_BAR;
    for (;;) {
        const bool has_next = P.next(ui + 1, nxt);
        if (has_next) P.a_off(nxt, R, Cc, aon);
        else { aon[0][0] = aoc[0][0]; aon[0][1] = aoc[0][1]; aon[1][0] = aoc[1][0]; aon[1][1] = aoc[1][1]; }
        const char* nB = has_next ? P.b_base(nxt) : cB;
        for (int t = 0; t < NKT; t += 2) {
            const bool last = (t == NKT - 2);
            const unsigned k1 = (unsigned)(t + 1) * (BK * 2);
            const unsigned k2 = last ? 0u : (unsigned)(t + 2) * (BK * 2), k3 = k2 + BK * 2;
            unsigned o2[2][2];
            o2[0][0] = last ? aon[0][0] : aoc[0][0]; o2[0][1] = last ? aon[0][1] : aoc[0][1];
            o2[1][0] = last ? aon[1][0] : aoc[1][0]; o2[1][1] = last ? aon[1][1] : aoc[1][1];
            const char* b2 = last ? nB : cB + (size_t)(t + 2) * (BK * 2); const char* b3 = b2 + BK * 2;
            PG8_LDB(B0, 0, 0); PG8_LDB(B1, 0, 1); PG8_SCHED; PG8_LDA(At, 0, 0); PG8_STAGE_A(PG8_SA(1, 1), aoc[1], k1);
            PG8_WAIT_V(8); PG8_WAIT_L(0); PG8_BAR; PG8_MMA(0, 0, At, B0); PG8_MMA(0, 1, At, B1); PG8_BAR; PG8_SCHED;
            PG8_LDA(At, 0, 1); PG8_STAGE_B(PG8_SB(0, 0), b2); PG8_STAGE_B(PG8_SB(0, 1), b2 + bh); PG8_STAGE_A(PG8_SA(0, 0), o2[0], k2);
            PG8_WAIT_V(8); PG8_WAIT_L(0); PG8_BAR; PG8_MMA(1, 0, At, B0); PG8_MMA(1, 1, At, B1); PG8_BAR; PG8_SCHED;
            PG8_LDB(B0, 1, 0); PG8_LDB(B1, 1, 1); PG8_SCHED; PG8_LDA(At, 1, 0); PG8_STAGE_A(PG8_SA(0, 1), o2[1], k2);
            PG8_WAIT_V(8); PG8_WAIT_L(0); PG8_BAR; PG8_MMA(0, 0, At, B0); PG8_MMA(0, 1, At, B1); PG8_BAR; PG8_SCHED;
            PG8_LDA(At, 1, 1); PG8_STAGE_B(PG8_SB(1, 0), b3); PG8_STAGE_B(PG8_SB(1, 1), b3 + bh); PG8_STAGE_A(PG8_SA(1, 0), o2[0], k3);
            PG8_WAIT_V(8); PG8_WAIT_L(0); PG8_BAR; PG8_MMA(1, 0, At, B0); PG8_MMA(1, 1, At, B1); PG8_BAR; PG8_SCHED;
        }
        PG8_WAIT_V(0);
        if (wr == 0) PG8_BAR;
        P.epi(acc, cur, wr, wc, fr, fq);
        if (PROBE_EPI) P.epi(acc, cur, wr, wc, fr, fq);
        if (!has_next) break;
#pragma unroll
        for (int a = 0; a < 2; ++a)
#pragma unroll
            for (int b = 0; b < 2; ++b)
#pragma unroll
                for (int m = 0; m < 4; ++m)
#pragma unroll
                    for (int n = 0; n < 2; ++n) acc[a][b][m][n] = (f32x4){0.f, 0.f, 0.f, 0.f};
        cur = nxt; cB = nB; ++ui;
        aoc[0][0] = aon[0][0]; aoc[0][1] = aon[0][1]; aoc[1][0] = aon[1][0]; aoc[1][1] = aon[1][1];
        if (wr == 1) PG8_BAR;
    }
    PG8_WAIT_V(0);
    PG8_BAR;
#undef PG8_SA
#undef PG8_SB
#undef PG8_STAGE_A
#undef PG8_STAGE_B
#undef PG8_LDA
#undef PG8_LDB
#undef PG8_MMA
#undef PG8_WAIT_V
#undef PG8_WAIT_L
#undef PG8_BAR
#undef PG8_SCHED
}
}

template <bool F8>
struct ProbInProjT {
    static constexpr bool PERM = true;
    const char* A; const char* Bt; bf16_t* PROJ; const float* cs; const float* lbt; int G, c;
    __device__ __forceinline__ bool next(int i, pg8::Unit& u) const {
        bool ok;
        if (F8) {
            long L;
            if (G == 256) { if (i < 5) L = (long)i * 256 + c; else if (c >= 128 && i < 7) L = 1280 + (c - 128) * 2 + (i - 5); else return false; }
            else L = (long)i * G + c;
            ok = pg8::static_map(L, T_ / 256, 12, u);
        } else {
            long L;
            if (G == 256) { if (i == 0) L = c; else if (i == 1 && c < 128) L = 256 + c; else return false; }
            else L = (long)i * G + c;
            ok = pg8::static_map(L, T_ / 256, 3, u); u.pn += 12;
        }
        u.ui = i; return ok;
    }
    __device__ __forceinline__ const char* a_base() const { return A; }
    __device__ __forceinline__ size_t b_hstep() const { return (size_t)128 * 1024 * (F8 ? 1 : 2); }
    __device__ __forceinline__ const char* b_base(const pg8::Unit& u) const { return Bt + (size_t)u.pn * 256 * 1024 * (F8 ? 1 : 2); }
    __device__ __forceinline__ void a_off(const pg8::Unit& u, const int (&R)[2], const int (&C)[2], unsigned (&off)[2][2]) const {
#pragma unroll
        for (int h = 0; h < 2; ++h)
#pragma unroll
            for (int i = 0; i < 2; ++i) off[h][i] = F8 ? (unsigned)((u.pm * 256 + 128 * h + R[i]) * 1024 + 2 * C[i]) : (unsigned)((u.pm * 256 + 128 * h + R[i]) * 1024 + C[i]) * 2u;
    }
    __device__ __forceinline__ void epi(const f32x4 (&acc)[2][2][4][2], const pg8::Unit& u, int wr, int wc, int fr, int fq) const {
        const int type = u.pn < 3 ? 0 : (u.pn < 6 ? 1 : (u.pn < 9 ? 2 : (u.pn < 12 ? 3 : (u.pn < 14 ? 4 : 5))));
        const int colb = u.pn * 256 + wc * 32 + 8 * fq;
        f32x4 lbv[2][2];
        if (type == 1) {
#pragma unroll
            for (int bj = 0; bj < 2; ++bj) { lbv[bj][0] = *(const f32x4*)(lbt + colb + 128 * bj - C_HF); lbv[bj][1] = *(const f32x4*)(lbt + colb + 128 * bj - C_HF + 4); }
        }
        const bool rot = (type == 4) && ((wc & 1) == 0) && (fq < 2);
#pragma unroll
        for (int ai = 0; ai < 2; ++ai)
#pragma unroll
            for (int m = 0; m < 4; ++m) {
                const int t = u.pm * 256 + ai * 128 + wr * 64 + m * 16 + fr;
                bf16_t* rowp = PROJ + (size_t)t * NPROJ + colb;
                f32x4 cv[2], sv[2];
                if (type == 4) { cv[0] = *(const f32x4*)(cs + t * 16); cv[1] = *(const f32x4*)(cs + t * 16 + 4); sv[0] = *(const f32x4*)(cs + t * 16 + 8); sv[1] = *(const f32x4*)(cs + t * 16 + 12); }
#pragma unroll
                for (int bj = 0; bj < 2; ++bj) {
                    f32x4 v[2] = {acc[ai][bj][m][0], acc[ai][bj][m][1]};
                    if (F8) { v[0] = v[0] * W8_INV; v[1] = v[1] * W8_INV; }
                    if (type == 0) {
#pragma unroll
                        for (int n = 0; n < 2; ++n)
#pragma unroll
                            for (int j = 0; j < 4; ++j) v[n][j] = siluf_(v[n][j]) * 0.08838834764831845f;
                    } else if (type == 1) {
#pragma unroll
                        for (int n = 0; n < 2; ++n)
#pragma unroll
                            for (int j = 0; j < 4; ++j) { const float lb = lbv[bj][n][j]; v[n][j] = __logf(lb + (1.f - lb) * sigmoidf_(v[n][j])); }
                    } else if (type == 3) {
#pragma unroll
                        for (int n = 0; n < 2; ++n)
#pragma unroll
                            for (int j = 0; j < 4; ++j) v[n][j] = siluf_(v[n][j]);
                    } else if (type == 4) {
#pragma unroll
                        for (int n = 0; n < 2; ++n)
#pragma unroll
                            for (int j = 0; j < 4; ++j) {
                                const float partner = __shfl_xor(v[n][j], 16);
                                const float r0 = v[n][j] * cv[n][j] - partner * sv[n][j], r1 = v[n][j] * cv[n][j] + partner * sv[n][j];
                                if (rot) v[n][j] = (fq == 0) ? r0 : r1;
                            }
                    }
                    u32x4 w; w.x = pg8::cvt_pk_bf16(v[0][0], v[0][1]); w.y = pg8::cvt_pk_bf16(v[0][2], v[0][3]); w.z = pg8::cvt_pk_bf16(v[1][0], v[1][1]); w.w = pg8::cvt_pk_bf16(v[1][2], v[1][3]);
                    *(u32x4*)(rowp + bj * 128) = w;
                }
            }
    }
};

struct ProbInProjFull : ProbInProjT<false> {
    __device__ __forceinline__ bool next(int i, pg8::Unit& u) const { return pg8::static_next(i, G, c, T_ / 256, NPROJ / 256, u); }
};
struct ProbOutProj {
    static constexpr bool PERM = true;
    const char* A; const char* Bt; const float* x; bf16_t* x1b; const float* mod; int G, c;
    __device__ __forceinline__ bool next(int i, pg8::Unit& u) const { return pg8::static_next(i, G, c, T_ / 256, D_ / 256, u); }
    __device__ __forceinline__ const char* a_base() const { return A; }
    __device__ __forceinline__ size_t b_hstep() const { return (size_t)128 * 1024 * 2; }
    __device__ __forceinline__ const char* b_base(const pg8::Unit& u) const { return Bt + (size_t)u.pn * 256 * 1024 * 2; }
    __device__ __forceinline__ void a_off(const pg8::Unit& u, const int (&R)[2], const int (&C)[2], unsigned (&off)[2][2]) const {
#pragma unroll
        for (int h = 0; h < 2; ++h)
#pragma unroll
            for (int i = 0; i < 2; ++i) off[h][i] = (unsigned)((u.pm * 256 + 128 * h + R[i]) * 1024 + C[i]) * 2u;
    }
    __device__ __forceinline__ void epi(const f32x4 (&acc)[2][2][4][2], const pg8::Unit& u, int wr, int wc, int fr, int fq) const {
        const int b = (u.pm * 256) / S_;
        const int col0 = u.pn * 256 + wc * 32 + 8 * fq;
        f32x4 gv[2][2];
#pragma unroll
        for (int bj = 0; bj < 2; ++bj)
#pragma unroll
            for (int n = 0; n < 2; ++n) gv[bj][n] = *(const f32x4*)(mod + b * NMOD + 2 * D_ + col0 + bj * 128 + n * 4);
#pragma unroll
        for (int ai = 0; ai < 2; ++ai)
#pragma unroll
            for (int m = 0; m < 4; ++m) {
                const size_t off = (size_t)(u.pm * 256 + ai * 128 + wr * 64 + m * 16 + fr) * D_ + col0;
#pragma unroll
                for (int bj = 0; bj < 2; ++bj) {
                    const f32x4 xs0 = *(const f32x4*)(x + off + bj * 128), xs1 = *(const f32x4*)(x + off + bj * 128 + 4);
                    const f32x4 v0 = xs0 + gv[bj][0] * acc[ai][bj][m][0], v1 = xs1 + gv[bj][1] * acc[ai][bj][m][1];
                    u32x4 w; w.x = pk2(v0[0], v0[1]); w.y = pk2(v0[2], v0[3]); w.z = pk2(v1[0], v1[1]); w.w = pk2(v1[2], v1[3]);
                    *(u32x4*)(x1b + off + bj * 128) = w;
                }
                asm volatile("" ::: "memory");
            }
    }
};

constexpr int MOE_TAB_OFF = pg8::STAGE_BYTES + 256;
constexpr int MOE_MAXU = 18;
template <int GEMM  >
struct ProbMoE {
    static constexpr bool PERM = true;
    static constexpr int GM = (GEMM == 1) ? 4 : 8, GN = (GEMM == 1) ? 8 : 4;
    const char* A; const char* Bt; bf16_t* O; const float* bias; const float* gate; const unsigned* ecnt; const int* elist;
    LAS int* pre; LAS int* tab; int G, c;
    __device__ __forceinline__ bool next(int i, pg8::Unit& u) const {
        const int v = (G % 8 == 0) ? (c % 8) * (G / 8) + c / 8 : c;
        const int Lv = i * G + v, grp = Lv / (GM * GN), within = Lv % (GM * GN);
        const int g = grp * GM + within / GN;
        if (g >= pre[NE_] || i >= MOE_MAXU) return false;
        int e = 0; while (pre[e + 1] <= g) ++e;
        u.e = e; u.pm = g - pre[e]; u.pn = within % GN; u.ui = i; return true;
    }
    __device__ __forceinline__ void fill_tab() const {
        for (int idx = tidx(); idx < MOE_MAXU * 256; idx += NTHREADS) {
            const int ui = idx >> 8, r = idx & 255; pg8::Unit u;
            int val = -1;
            if (next(ui, u)) { const int cnt = (int)ecnt[u.e], li = u.pm * 256 + r; val = (li < cnt) ? elist[u.e * 32768 + li] : (-elist[u.e * 32768 + u.pm * 256] - 1); }
            tab[idx] = val;
        }
    }
    __device__ __forceinline__ const char* a_base() const { return A; }
    __device__ __forceinline__ size_t b_hstep() const { return (GEMM == 1) ? (size_t)1024 * 1024 * 2 : (size_t)128 * 1024 * 2; }
    __device__ __forceinline__ const char* b_base(const pg8::Unit& u) const {
        return (GEMM == 1) ? Bt + ((size_t)u.e * 2048 + (size_t)u.pn * 128) * 1024 * 2 : Bt + ((size_t)u.e * 1024 + (size_t)u.pn * 256) * 1024 * 2;
    }
    __device__ __forceinline__ void a_off(const pg8::Unit& u, const int (&R)[2], const int (&C)[2], unsigned (&off)[2][2]) const {
#pragma unroll
        for (int h = 0; h < 2; ++h)
#pragma unroll
            for (int i = 0; i < 2; ++i) { int en = tab[u.ui * 256 + 128 * h + R[i]]; en = en < 0 ? (-en - 1) : en; const int row = (GEMM == 1) ? (en >> 2) : en; off[h][i] = (unsigned)(row * 1024 + C[i]) * 2u; }
    }
    __device__ __forceinline__ void epi(const f32x4 (&acc)[2][2][4][2], const pg8::Unit& u, int wr, int wc, int fr, int fq) const {
        if (GEMM == 1) {
            const int c0 = u.pn * 128 + wc * 32 + 8 * fq;
            const f32x4 bg0 = *(const f32x4*)(bias + u.e * 2048 + c0), bg1 = *(const f32x4*)(bias + u.e * 2048 + c0 + 4);
            const f32x4 bu0 = *(const f32x4*)(bias + u.e * 2048 + 1024 + c0), bu1 = *(const f32x4*)(bias + u.e * 2048 + 1024 + c0 + 4);
#pragma unroll
            for (int ai = 0; ai < 2; ++ai)
#pragma unroll
                for (int m = 0; m < 4; ++m) {
                    const int en = tab[u.ui * 256 + ai * 128 + wr * 64 + m * 16 + fr];
                    f32x4 g0 = acc[ai][0][m][0] + bg0, g1 = acc[ai][0][m][1] + bg1, u0 = acc[ai][1][m][0] + bu0, u1 = acc[ai][1][m][1] + bu1;
                    float a[8];
#pragma unroll
                    for (int j = 0; j < 4; ++j) {
                        const float gv0 = fminf(g0[j], 7.f), uv0 = fminf(fmaxf(u0[j], -7.f), 7.f); a[j] = (uv0 + 1.f) * gv0 * sigmoidf_(1.702f * gv0);
                        const float gv1 = fminf(g1[j], 7.f), uv1 = fminf(fmaxf(u1[j], -7.f), 7.f); a[4 + j] = (uv1 + 1.f) * gv1 * sigmoidf_(1.702f * gv1);
                    }
                    if (en >= 0) { u32x4 w; w.x = pg8::cvt_pk_bf16(a[0], a[1]); w.y = pg8::cvt_pk_bf16(a[2], a[3]); w.z = pg8::cvt_pk_bf16(a[4], a[5]); w.w = pg8::cvt_pk_bf16(a[6], a[7]);
                        *(u32x4*)(O + (size_t)en * DFF_ + c0) = w; }
                }
        } else {
            const int c0 = u.pn * 256 + wc * 32 + 8 * fq;
            f32x4 bv[2][2];
#pragma unroll
            for (int bj = 0; bj < 2; ++bj) { bv[bj][0] = *(const f32x4*)(bias + u.e * 1024 + c0 + 128 * bj); bv[bj][1] = *(const f32x4*)(bias + u.e * 1024 + c0 + 128 * bj + 4); }
#pragma unroll
            for (int ai = 0; ai < 2; ++ai)
#pragma unroll
                for (int m = 0; m < 4; ++m) {
                    const int en = tab[u.ui * 256 + ai * 128 + wr * 64 + m * 16 + fr];
                    if (en >= 0) {
                        const float gt = gate[en];
#pragma unroll
                        for (int bj = 0; bj < 2; ++bj) { const f32x4 v0 = (acc[ai][bj][m][0] + bv[bj][0]) * gt, v1 = (acc[ai][bj][m][1] + bv[bj][1]) * gt;
                            u32x4 w; w.x = pg8::cvt_pk_bf16(v0[0], v0[1]); w.y = pg8::cvt_pk_bf16(v0[2], v0[3]); w.z = pg8::cvt_pk_bf16(v1[0], v1[1]); w.w = pg8::cvt_pk_bf16(v1[2], v1[3]);
                            *(u32x4*)(O + (size_t)en * D_ + c0 + 128 * bj) = w; }
                    }
                }
        }
    }
};


namespace pg8 {
typedef int i32x8 __attribute__((ext_vector_type(8)));
typedef int i32x4 __attribute__((ext_vector_type(4)));
template <class Prob>
__device__ __forceinline__ void gemm_phase8(LAS unsigned char* lds, const Prob& P) {
    constexpr int ROWB = 1024, NKT8 = ROWB / 128;
    const int tid = tidx(), wid = __builtin_amdgcn_readfirstlane(tid >> 6), lane = tid & 63, wr = wid >> 2, wc = wid & 3, fr = lane & 15, fq = lane >> 4;
    int R[2], Cc[2]; unsigned voffB[2];
#pragma unroll
    for (int i = 0; i < 2; ++i) { stage_rc(tid * 16 + i * 8192, R[i], Cc[i]); const int Rb = Prob::PERM ? ((R[i] & ~31) + perm32(R[i] & 31)) : R[i]; voffB[i] = (unsigned)(Rb * ROWB + 2 * Cc[i]); }
    const unsigned ldsw = (unsigned)wid * 1024u;
    const int aoff0 = lds_byte(wr * 64 + fr, fq * 8), boff0 = lds_byte(wc * 32 + fr, fq * 8);
#define PG8_SA(b, h) (((b) * 2 + (h)) * HTB)
#define PG8_SB(b, h) ((4 + (b) * 2 + (h)) * HTB)
#define PG8_STAGE_B(bufoff, gbase) do { _Pragma("unroll") for (int _i = 0; _i < 2; ++_i) \
        __builtin_amdgcn_global_load_lds((const unsigned*)((const char*)(gbase) + voffB[_i]), (LAS unsigned*)(lds + (bufoff) + ldsw + _i * 8192), 16, 0, 0); } while (0)
#define PG8_STAGE_A(bufoff, o, kb) do { _Pragma("unroll") for (int _i = 0; _i < 2; ++_i) \
        __builtin_amdgcn_global_load_lds((const unsigned*)(Ab + ((o)[_i] + (unsigned)(kb))), (LAS unsigned*)(lds + (bufoff) + ldsw + _i * 8192), 16, 0, 0); } while (0)
#define PG8_CAT(x, y) __builtin_shufflevector((x), (y), 0, 1, 2, 3, 4, 5, 6, 7)
#define PG8_LDA(dst, b, h) do { _Pragma("unroll") for (int m = 0; m < 4; ++m) { dst[m].lo = *(const LAS i32x4*)(lds + PG8_SA(b, h) + aoff0 + m * 2048); dst[m].hi = *(const LAS i32x4*)(lds + PG8_SA(b, h) + aoff0 + m * 2048 + 1024); } } while (0)
#define PG8_LDB(dst, b, h) do { _Pragma("unroll") for (int n = 0; n < 2; ++n) { dst[n].lo = *(const LAS i32x4*)(lds + PG8_SB(b, h) + boff0 + n * 2048); dst[n].hi = *(const LAS i32x4*)(lds + PG8_SB(b, h) + boff0 + n * 2048 + 1024); } } while (0)
#define PG8_MMA(ai, bj, At, Bt) do { __builtin_amdgcn_s_setprio(1); _Pragma("unroll") for (int m = 0; m < 4; ++m) _Pragma("unroll") for (int n = 0; n < 2; ++n) \
        asm volatile("v_mfma_f32_16x16x128_f8f6f4 %0, %1, %2, %0" : "+v"(acc[ai][bj][m][n]) : "v"(Bt[n]), "v"(At[m])); __builtin_amdgcn_s_setprio(0); } while (0)
#define PG8_WAIT_V(n) asm volatile("s_waitcnt vmcnt(" #n ")" ::: "memory")
#define PG8_WAIT_L(n) asm volatile("s_waitcnt lgkmcnt(" #n ")" ::: "memory")
#define PG8_BAR __builtin_amdgcn_s_barrier()
#define PG8_SCHED __builtin_amdgcn_sched_barrier(0)
    Unit cur, nxt; int ui = 0;
    if (!P.next(0, cur)) return;
    f32x4 acc[2][2][4][2];
#pragma unroll
    for (int a = 0; a < 2; ++a)
#pragma unroll
        for (int b = 0; b < 2; ++b)
#pragma unroll
            for (int m = 0; m < 4; ++m)
#pragma unroll
                for (int n = 0; n < 2; ++n) acc[a][b][m][n] = (f32x4){0.f, 0.f, 0.f, 0.f};
#define PG8_PIN_ACC() do { _Pragma("unroll") for (int a = 0; a < 2; ++a) _Pragma("unroll") for (int b = 0; b < 2; ++b) _Pragma("unroll") for (int m = 0; m < 4; ++m) _Pragma("unroll") for (int n = 0; n < 2; ++n) asm volatile("" : "+v"(acc[a][b][m][n])); } while (0)
    PG8_PIN_ACC();
    i32x8 At[4], B0[2], B1[2];
    int sc1 = 0x7F7F7F7F; asm volatile("" : "+v"(sc1));
    const char* Ab = P.a_base();
    const size_t bh = P.b_hstep();
    unsigned aoc[2][2], aon[2][2];
    P.a_off(cur, R, Cc, aoc);
    const char* cB = P.b_base(cur);
    PG8_STAGE_B(PG8_SB(0, 0), cB); PG8_STAGE_B(PG8_SB(0, 1), cB + bh); PG8_STAGE_A(PG8_SA(0, 0), aoc[0], 0); PG8_STAGE_A(PG8_SA(0, 1), aoc[1], 0);
    if (wr == 1) PG8_BAR;
    PG8_WAIT_V(2); PG8_BAR;
    PG8_STAGE_B(PG8_SB(1, 0), cB + 128); PG8_STAGE_A(PG8_SA(1, 0), aoc[0], 128); PG8_STAGE_B(PG8_SB(1, 1), cB + bh + 128);
    PG8_WAIT_V(6); PG8_BAR;
    for (;;) {
        const bool has_next = P.next(ui + 1, nxt);
        if (has_next) P.a_off(nxt, R, Cc, aon);
        else { aon[0][0] = aoc[0][0]; aon[0][1] = aoc[0][1]; aon[1][0] = aoc[1][0]; aon[1][1] = aoc[1][1]; }
        const char* nB = has_next ? P.b_base(nxt) : cB;
        for (int t = 0; t < NKT8; t += 2) {
            const bool fresh = (t == 0) && (ui > 0);
            const bool last = (t == NKT8 - 2);
            const unsigned k1 = (unsigned)(t + 1) * 128u;
            const unsigned k2 = last ? 0u : (unsigned)(t + 2) * 128u, k3 = k2 + 128u;
            unsigned o2[2][2];
            o2[0][0] = last ? aon[0][0] : aoc[0][0]; o2[0][1] = last ? aon[0][1] : aoc[0][1];
            o2[1][0] = last ? aon[1][0] : aoc[1][0]; o2[1][1] = last ? aon[1][1] : aoc[1][1];
            const char* b2 = last ? nB : cB + (size_t)(t + 2) * 128; const char* b3 = b2 + 128;
            PG8_LDB(B0, 0, 0); PG8_LDB(B1, 0, 1); PG8_SCHED; PG8_LDA(At, 0, 0); PG8_STAGE_A(PG8_SA(1, 1), aoc[1], k1);
            if (!fresh) PG8_WAIT_V(8); PG8_WAIT_L(0); PG8_BAR; PG8_MMA(0, 0, At, B0); PG8_MMA(0, 1, At, B1); PG8_BAR; PG8_SCHED;
            PG8_LDA(At, 0, 1); PG8_STAGE_B(PG8_SB(0, 0), b2); PG8_STAGE_B(PG8_SB(0, 1), b2 + bh); PG8_STAGE_A(PG8_SA(0, 0), o2[0], k2);
            if (!fresh) PG8_WAIT_V(8); PG8_WAIT_L(0); PG8_BAR; PG8_MMA(1, 0, At, B0); PG8_MMA(1, 1, At, B1); PG8_BAR; PG8_SCHED;
            PG8_LDB(B0, 1, 0); PG8_LDB(B1, 1, 1); PG8_SCHED; PG8_LDA(At, 1, 0); PG8_STAGE_A(PG8_SA(0, 1), o2[1], k2);
            PG8_WAIT_V(8); PG8_WAIT_L(0); PG8_BAR; PG8_MMA(0, 0, At, B0); PG8_MMA(0, 1, At, B1); PG8_BAR; PG8_SCHED;
            PG8_LDA(At, 1, 1); PG8_STAGE_B(PG8_SB(1, 0), b3); PG8_STAGE_B(PG8_SB(1, 1), b3 + bh); PG8_STAGE_A(PG8_SA(1, 0), o2[0], k3);
            PG8_WAIT_V(8); PG8_WAIT_L(0); PG8_BAR; PG8_MMA(1, 0, At, B0); PG8_MMA(1, 1, At, B1); PG8_BAR; PG8_SCHED;
        }
        asm volatile("s_nop 15\n\ts_nop 15" ::: "memory");
        PG8_WAIT_V(0);
        if (wr == 0) PG8_BAR;
        P.epi(acc, cur, wr, wc, fr, fq);
        if (PROBE_EPI) P.epi(acc, cur, wr, wc, fr, fq);
        if (!has_next) break;
#pragma unroll
        for (int a = 0; a < 2; ++a)
#pragma unroll
            for (int b = 0; b < 2; ++b)
#pragma unroll
                for (int m = 0; m < 4; ++m)
#pragma unroll
                    for (int n = 0; n < 2; ++n) acc[a][b][m][n] = (f32x4){0.f, 0.f, 0.f, 0.f};
        PG8_PIN_ACC();
        cur = nxt; cB = nB; ++ui;
        aoc[0][0] = aon[0][0]; aoc[0][1] = aon[0][1]; aoc[1][0] = aon[1][0]; aoc[1][1] = aon[1][1];
        if (wr == 1) PG8_BAR;
    }
    PG8_WAIT_V(0);
    PG8_BAR;
#undef PG8_SA
#undef PG8_SB
#undef PG8_STAGE_A
#undef PG8_STAGE_B
#undef PG8_CAT
#undef PG8_LDA
#undef PG8_LDB
#undef PG8_MMA
#undef PG8_WAIT_V
#undef PG8_WAIT_L
#undef PG8_BAR
#undef PG8_SCHED
}
}


template <int GEMM  >
struct ProbMoE8 {
    static constexpr bool PERM = true;
    static constexpr int GM = (GEMM == 1) ? 4 : 8, GN = (GEMM == 1) ? 8 : 4;
    const char* A; const char* Bt; unsigned char* O; const float* bias; const float* gate; const unsigned* ecnt; const int* elist;
    LAS int* pre; LAS int* tab; LAS int* uinf; int G, c;
    __device__ __forceinline__ bool next_slow(int i, pg8::Unit& u) const {
        const int v = (G % 8 == 0) ? (c % 8) * (G / 8) + c / 8 : c;
        const int Lv = i * G + v, grp = Lv / (GM * GN), within = Lv % (GM * GN);
        const int g = grp * GM + within / GN;
        if (g >= pre[NE_] || i >= MOE_MAXU) return false;
        int e = 0; while (pre[e + 1] <= g) ++e;
        u.e = e; u.pm = g - pre[e]; u.pn = within % GN; u.ui = i; return true;
    }
    __device__ __forceinline__ bool next(int i, pg8::Unit& u) const {
        if (i >= MOE_MAXU) return false;
        const int v = uinf[i]; if (v < 0) return false;
        u.e = v & 63; u.pm = (v >> 6) & 16383; u.pn = v >> 20; u.ui = i; return true;
    }
    __device__ __forceinline__ void fill_tab() const {
        if (tidx() < MOE_MAXU) { pg8::Unit u; uinf[tidx()] = next_slow(tidx(), u) ? (u.e | (u.pm << 6) | (u.pn << 20)) : -1; }
        __syncthreads();
        for (int idx = tidx(); idx < MOE_MAXU * 256; idx += NTHREADS) {
            const int ui = idx >> 8, r = idx & 255; pg8::Unit u;
            int val = -1;
            if (next(ui, u)) { const int cnt = (int)ecnt[u.e], li = u.pm * 256 + r; val = (li < cnt) ? elist[u.e * 32768 + li] : (-elist[u.e * 32768 + u.pm * 256] - 1); }
            tab[idx] = val;
        }
    }
    __device__ __forceinline__ const char* a_base() const { return A; }
    __device__ __forceinline__ size_t b_hstep() const { return (GEMM == 1) ? (size_t)1024 * 1024 : (size_t)128 * 1024; }
    __device__ __forceinline__ const char* b_base(const pg8::Unit& u) const {
        return (GEMM == 1) ? Bt + ((size_t)u.e * 2048 + (size_t)u.pn * 128) * 1024 : Bt + ((size_t)u.e * 1024 + (size_t)u.pn * 256) * 1024;
    }
    __device__ __forceinline__ void a_off(const pg8::Unit& u, const int (&R)[2], const int (&C)[2], unsigned (&off)[2][2]) const {
#pragma unroll
        for (int h = 0; h < 2; ++h)
#pragma unroll
            for (int i = 0; i < 2; ++i) { int en = tab[u.ui * 256 + 128 * h + R[i]]; en = en < 0 ? (-en - 1) : en; const int row = (GEMM == 1) ? (en >> 2) : en; off[h][i] = (unsigned)(row * 1024 + 2 * C[i]); }
    }
    __device__ __forceinline__ void epi(const f32x4 (&acc)[2][2][4][2], const pg8::Unit& u, int wr, int wc, int fr, int fq) const {
        if (GEMM == 1) {
            const int c0 = u.pn * 128 + wc * 32 + 8 * fq;
            const f32x4 bg0 = *(const f32x4*)(bias + u.e * 2048 + c0), bg1 = *(const f32x4*)(bias + u.e * 2048 + c0 + 4);
            const f32x4 bu0 = *(const f32x4*)(bias + u.e * 2048 + 1024 + c0), bu1 = *(const f32x4*)(bias + u.e * 2048 + 1024 + c0 + 4);
#pragma unroll
            for (int ai = 0; ai < 2; ++ai)
#pragma unroll
                for (int m = 0; m < 4; ++m) {
                    const int en = tab[u.ui * 256 + ai * 128 + wr * 64 + m * 16 + fr];
                    f32x4 g0 = acc[ai][0][m][0] * W8_INV + bg0, g1 = acc[ai][0][m][1] * W8_INV + bg1, u0 = acc[ai][1][m][0] * W8_INV + bu0, u1 = acc[ai][1][m][1] * W8_INV + bu1;
                    float a[8];
#pragma unroll
                    for (int j = 0; j < 4; ++j) {
                        const float gv0 = fminf(g0[j], 7.f), uv0 = fminf(fmaxf(u0[j], -7.f), 7.f); a[j] = (uv0 + 1.f) * gv0 * sigmoidf_(1.702f * gv0);
                        const float gv1 = fminf(g1[j], 7.f), uv1 = fminf(fmaxf(u1[j], -7.f), 7.f); a[4 + j] = (uv1 + 1.f) * gv1 * sigmoidf_(1.702f * gv1);
                    }
                    if (en >= 0) { uint2 w; w.x = pk4_fp8(a[0], a[1], a[2], a[3]); w.y = pk4_fp8(a[4], a[5], a[6], a[7]); *(uint2*)(O + (size_t)en * DFF_ + c0) = w; }
                }
        } else {
            const int c0 = u.pn * 256 + wc * 32 + 8 * fq;
            f32x4 bv[2][2];
#pragma unroll
            for (int bj = 0; bj < 2; ++bj) { bv[bj][0] = *(const f32x4*)(bias + u.e * 1024 + c0 + 128 * bj); bv[bj][1] = *(const f32x4*)(bias + u.e * 1024 + c0 + 128 * bj + 4); }
#pragma unroll
            for (int ai = 0; ai < 2; ++ai)
#pragma unroll
                for (int m = 0; m < 4; ++m) {
                    const int en = tab[u.ui * 256 + ai * 128 + wr * 64 + m * 16 + fr];
                    if (en >= 0) {
                        const float gt = gate[en] * OUT2_SCALE;
#pragma unroll
                        for (int bj = 0; bj < 2; ++bj) { const f32x4 v0 = (acc[ai][bj][m][0] * W8_INV + bv[bj][0]) * gt, v1 = (acc[ai][bj][m][1] * W8_INV + bv[bj][1]) * gt;
#define CL8(x) fminf(fmaxf((x), -448.f), 448.f)
                            uint2 w; w.x = pk4_fp8(CL8(v0[0]), CL8(v0[1]), CL8(v0[2]), CL8(v0[3])); w.y = pk4_fp8(CL8(v1[0]), CL8(v1[1]), CL8(v1[2]), CL8(v1[3]));
#undef CL8
                            *(uint2*)(O + (size_t)en * D_ + c0 + 128 * bj) = w; }
                    }
                }
        }
    }
};

template <int GEMM>
__device__ __forceinline__ void phase_moe_fast8(const Params& p, int bid, int nb, LAS unsigned char* lds) {
    const unsigned* ecnt = (const unsigned*)(p.ws + OFF_CTL) + CW_ECNT;
    LAS int* pre = (LAS int*)(lds + pg8::STAGE_BYTES);
    LAS int* tab = (LAS int*)(lds + MOE_TAB_OFF);
    __syncthreads();
    if (tidx() == 0) { int a = 0; for (int e = 0; e < NE_; ++e) { pre[e] = a; a += ((int)ecnt[e] + 255) / 256; } pre[NE_] = a; }
    __syncthreads();
    ProbMoE8<GEMM> P{(const char*)(p.ws + (GEMM == 1 ? OFF_H : OFF_ACT)), (const char*)(p.ws + (GEMM == 1 ? OFF_WGU : OFF_WDN)), (unsigned char*)(p.ws + (GEMM == 1 ? OFF_ACT : OFF_OUT2)),
                     GEMM == 1 ? p.b_gu : p.b_dn, (const float*)(p.ws + OFF_GATE), ecnt, (const int*)(p.ws + OFF_ELIST), pre, tab, (LAS int*)(lds + pg8::STAGE_BYTES + 160), nb, bid};
    P.fill_tab();
    __syncthreads();
    pg8::gemm_phase8(lds, P);
}

__device__ __forceinline__ void phase2_fast(const Params& p, int bid, int nb, LAS unsigned char* lds) {
    if (INPROJ_FP8) {
        ProbInProjT<true> P8{(const char*)(p.ws + OFF_H8), (const char*)(p.ws + OFF_WIN8), (bf16_t*)(p.ws + OFF_PROJ), (const float*)(p.ws + OFF_CS), (const float*)(p.ws + OFF_LB), nb, bid};
        pg8::gemm_phase8(lds, P8);
        ProbInProjT<false> P{(const char*)(p.ws + OFF_H), (const char*)(p.ws + OFF_WIN), (bf16_t*)(p.ws + OFF_PROJ), (const float*)(p.ws + OFF_CS), (const float*)(p.ws + OFF_LB), nb, bid};
        pg8::gemm_phase(lds, P);
    } else {
        ProbInProjFull P{(const char*)(p.ws + OFF_H), (const char*)(p.ws + OFF_WIN), (bf16_t*)(p.ws + OFF_PROJ), (const float*)(p.ws + OFF_CS), (const float*)(p.ws + OFF_LB), nb, bid};
        pg8::gemm_phase(lds, P);
    }
}
__device__ __forceinline__ void phase5_fast(const Params& p, int bid, int nb, LAS unsigned char* lds) {
    ProbOutProj P{(const char*)(p.ws + OFF_MIX), (const char*)(p.ws + OFF_WOUT), p.x, (bf16_t*)(p.ws + OFF_X1B), (const float*)(p.ws + OFF_MOD), nb, bid};
    pg8::gemm_phase(lds, P);
}
template <int GEMM>
__device__ __forceinline__ void phase_moe_fast(const Params& p, int bid, int nb, LAS unsigned char* lds) {
    const unsigned* ecnt = (const unsigned*)(p.ws + OFF_CTL) + CW_ECNT;
    LAS int* pre = (LAS int*)(lds + pg8::STAGE_BYTES);
    LAS int* tab = (LAS int*)(lds + MOE_TAB_OFF);
    __syncthreads();
    if (tidx() == 0) { int a = 0; for (int e = 0; e < NE_; ++e) { pre[e] = a; a += ((int)ecnt[e] + 255) / 256; } pre[NE_] = a; }
    __syncthreads();
    ProbMoE<GEMM> P{(const char*)(p.ws + (GEMM == 1 ? OFF_H : OFF_ACT)), (const char*)(p.ws + (GEMM == 1 ? OFF_WGU : OFF_WDN)), (bf16_t*)(p.ws + (GEMM == 1 ? OFF_ACT : OFF_OUT2)),
                    GEMM == 1 ? p.b_gu : p.b_dn, (const float*)(p.ws + OFF_GATE), ecnt, (const int*)(p.ws + OFF_ELIST), pre, tab, nb, bid};
    P.fill_tab();
    __syncthreads();
    pg8::gemm_phase(lds, P);
}

__device__ __forceinline__ void phase2(const Params& p, int bid, int nb) {
    const int lane = tidx() & 63, wave = tidx() >> 6, lr = lane & 15, g = lane >> 4;
    const bf16_t* H = (const bf16_t*)(p.ws + OFF_H);
    const bf16_t* WT = (const bf16_t*)(p.ws + OFF_WIN);
    bf16_t* PROJ = (bf16_t*)(p.ws + OFF_PROJ);
    const float* cs = (const float*)(p.ws + OFF_CS);
    constexpr int NMT = T_ / 128, NNT = NPROJ / 64;
    for (int u = bid; u < NMT * NNT; u += nb) {
        const int mt = u / NNT, nt = u % NNT;
        const int row0 = mt * 128 + wave * 16, col0 = nt * 64;
        const bf16_t* arow = H + (size_t)(row0 + lr) * D_;
        const bf16_t* bcol[4];
#pragma unroll
        for (int n = 0; n < 4; ++n) bcol[n] = WT + (size_t)(col0 + 16 * n + lr) * D_;
        f32x4 acc[4];
        wave_gemm<4>(arow, bcol, D_, acc);
#pragma unroll
        for (int n = 0; n < 4; ++n) {
            const int c = col0 + 16 * n + lr;
#pragma unroll
            for (int j = 0; j < 4; ++j) {
                const int t = row0 + 4 * g + j;
                float v = acc[n][j], o;
                if (c < C_HF) o = siluf_(v) * 0.08838834764831845f;
                else if (c < C_HI) {
                    const int jj = c - C_HF;
                    const float lb = 1.f / (1.f + expf(p.lb_logits[HW_ + jj] - p.lb_logits[jj]));
                    const float f = lb + (1.f - lb) * sigmoidf_(v);
                    o = logf(f);
                } else if (c < C_HG) o = v;
                else if (c < C_AQ) o = siluf_(v);
                else if (c < C_AV) {
                    const float partner = __shfl_xor(v, 8);
                    if (n == 0) {
                        const int i = lr & 7;
                        const float cv = cs[t * 16 + i], sv = cs[t * 16 + 8 + i];
                        o = (lr < 8) ? (v * cv - partner * sv) : (v * cv + partner * sv);
                    } else o = v;
                } else o = v;
                PROJ[(size_t)t * NPROJ + c] = f2bf(o);
            }
        }
    }
}

__device__ __forceinline__ void phase3(const Params& p, int bid, int nb) {
    const int lane = tidx() & 63, wave = tidx() >> 6;
    const bf16_t* PROJ = (const bf16_t*)(p.ws + OFF_PROJ);
    float* OH = (float*)(p.ws + OFF_U);
    if (!HG_FAST) for (int w = bid * NWAVES + wave; w < NB_ * NHH * 128; w += nb * NWAVES) {
        const int v = w & 127, h = (w >> 7) % NHH, b = w / (NHH * 128);
        float S0 = 0.f, S1 = 0.f;
        const bf16_t* base = PROJ + (size_t)b * S_ * NPROJ + h * 128;
#pragma unroll 4
        for (int s = 0; s < S_; ++s) {
            const bf16_t* r = base + (size_t)s * NPROJ;
            const float q0 = bf2f(r[C_HQ + lane]), q1 = bf2f(r[C_HQ + 64 + lane]);
            const float f0 = __expf(bf2f(r[C_HF + lane])), f1 = __expf(bf2f(r[C_HF + 64 + lane]));
            const float vv = bf2f(r[C_HI + v]);
            S0 = f0 * S0 + (1.f - f0) * vv; S1 = f1 * S1 + (1.f - f1) * vv;
            const float o = wave_sum(S0 * q0 + S1 * q1);
            if (lane == 0) OH[(size_t)(b * S_ + s) * HW_ + h * 128 + v] = o;
        }
    }
    float* KM = (float*)(p.ws + OFF_KM);
    if (!MB_FAST) for (int i = bid * NTHREADS + tidx(); i < NB_ * AHN * 64 * 64; i += nb * NTHREADS) {
        const int d = i & 63, j = (i >> 6) & 63, h = (i >> 12) & 3, b = i >> 14;
        const bf16_t* kp = PROJ + (size_t)(b * S_ + j * 256) * NPROJ + C_AK + h * 64 + d;
        float s = 0.f;
        for (int k = 0; k < 256; ++k) s += bf2f(kp[(size_t)k * NPROJ]);
        KM[i] = s * (1.f / 256.f);
    }
}

__device__ __forceinline__ void phase4(const Params& p, int bid, int nb) {
    const int lane = tidx() & 63, wave = tidx() >> 6;
    const bf16_t* PROJ = (const bf16_t*)(p.ws + OFF_PROJ);
    const float* OH = (const float*)(p.ws + OFF_U);
    bf16_t* MIX = (bf16_t*)(p.ws + OFF_MIX);
    if (!HG_FAST) for (int w = bid * NWAVES + wave; w < T_ * NHH; w += nb * NWAVES) {
        const int t = w / NHH, h = w % NHH;
        const float o0 = OH[(size_t)t * HW_ + h * 128 + lane], o1 = OH[(size_t)t * HW_ + h * 128 + 64 + lane];
        const float rstd = rsqrtf(wave_sum(o0 * o0 + o1 * o1) * (1.f / 128.f) + RMS_EPS);
        const float g0 = bf2f(PROJ[(size_t)t * NPROJ + C_HG + h * 128 + lane]), g1 = bf2f(PROJ[(size_t)t * NPROJ + C_HG + h * 128 + 64 + lane]);
        MIX[(size_t)t * D_ + h * 128 + lane] = f2bf(o0 * rstd * p.hgrn_norm_g[lane] * g0);
        MIX[(size_t)t * D_ + h * 128 + 64 + lane] = f2bf(o1 * rstd * p.hgrn_norm_g[64 + lane] * g1);
    }
    const float* KM = (const float*)(p.ws + OFF_KM);
    if (!MB_FAST) for (int idx = bid * NTHREADS + tidx(); idx < NB_ * AHN * S_; idx += nb * NTHREADS) {
        const int q = idx & (S_ - 1), h = (idx >> 14) & 3, b = idx >> 16;
        const int t = b * S_ + q, own = q >> 8;
        float qv[64];
        {
            const u32x4* qp = (const u32x4*)(PROJ + (size_t)t * NPROJ + C_AQ + h * 64);
#pragma unroll
            for (int c = 0; c < 8; ++c) { const u32x4 w = qp[c];
                qv[8 * c + 0] = __uint_as_float(w.x << 16); qv[8 * c + 1] = __uint_as_float(w.x & 0xffff0000u);
                qv[8 * c + 2] = __uint_as_float(w.y << 16); qv[8 * c + 3] = __uint_as_float(w.y & 0xffff0000u);
                qv[8 * c + 4] = __uint_as_float(w.z << 16); qv[8 * c + 5] = __uint_as_float(w.z & 0xffff0000u);
                qv[8 * c + 6] = __uint_as_float(w.w << 16); qv[8 * c + 7] = __uint_as_float(w.w & 0xffff0000u); }
        }
        float v0 = -INFINITY, v1 = -INFINITY, v2 = -INFINITY; int i0 = 0, i1 = 0, i2 = 0;
        for (int j = 0; j < own; ++j) {
            const float* km = KM + ((size_t)(b * AHN + h) * 64 + j) * 64;
            float gt = 0.f;
#pragma unroll
            for (int d = 0; d < 64; ++d) gt += qv[d] * km[d];
            if (gt > v0) { v2 = v1; i2 = i1; v1 = v0; i1 = i0; v0 = gt; i0 = j; }
            else if (gt > v1) { v2 = v1; i2 = i1; v1 = gt; i1 = j; }
            else if (gt > v2) { v2 = gt; i2 = j; }
        }
        const int nsel = own < 3 ? own : 3;
        float m = -INFINITY, l = 0.f, ov[64];
#pragma unroll
        for (int d = 0; d < 64; ++d) ov[d] = 0.f;
        for (int sidx = 0; sidx <= nsel; ++sidx) {
            const int blk = (sidx == nsel) ? own : (sidx == 0 ? i0 : (sidx == 1 ? i1 : i2));
            const int nk = (sidx == nsel) ? ((q & 255) + 1) : 256;
            const bf16_t* kb = PROJ + (size_t)(b * S_ + blk * 256) * NPROJ + C_AK + h * 64;
            for (int k = 0; k < nk; ++k) {
                const u32x4* kp = (const u32x4*)(kb + (size_t)k * NPROJ);
                float s = 0.f;
#pragma unroll
                for (int c = 0; c < 8; ++c) { const u32x4 w = kp[c];
                    s += qv[8 * c + 0] * __uint_as_float(w.x << 16) + qv[8 * c + 1] * __uint_as_float(w.x & 0xffff0000u)
                       + qv[8 * c + 2] * __uint_as_float(w.y << 16) + qv[8 * c + 3] * __uint_as_float(w.y & 0xffff0000u)
                       + qv[8 * c + 4] * __uint_as_float(w.z << 16) + qv[8 * c + 5] * __uint_as_float(w.z & 0xffff0000u)
                       + qv[8 * c + 6] * __uint_as_float(w.w << 16) + qv[8 * c + 7] * __uint_as_float(w.w & 0xffff0000u); }
                s *= 0.125f;
                if (s > m) { const float corr = __expf(m - s); l *= corr;
#pragma unroll
                    for (int d = 0; d < 64; ++d) ov[d] *= corr;
                    m = s; }
                const float pr = __expf(s - m); l += pr;
                const u32x4* vp = (const u32x4*)(kb + (size_t)k * NPROJ + (C_AV - C_AK));
#pragma unroll
                for (int c = 0; c < 8; ++c) { const u32x4 w = vp[c];
                    ov[8 * c + 0] += pr * __uint_as_float(w.x << 16); ov[8 * c + 1] += pr * __uint_as_float(w.x & 0xffff0000u);
                    ov[8 * c + 2] += pr * __uint_as_float(w.y << 16); ov[8 * c + 3] += pr * __uint_as_float(w.y & 0xffff0000u);
                    ov[8 * c + 4] += pr * __uint_as_float(w.z << 16); ov[8 * c + 5] += pr * __uint_as_float(w.z & 0xffff0000u);
                    ov[8 * c + 6] += pr * __uint_as_float(w.w << 16); ov[8 * c + 7] += pr * __uint_as_float(w.w & 0xffff0000u); }
            }
        }
        const float inv = 1.f / l; float ss = 0.f;
#pragma unroll
        for (int d = 0; d < 64; ++d) { ov[d] *= inv; ss += ov[d] * ov[d]; }
        const float rstd = rsqrtf(ss * (1.f / 64.f) + RMS_EPS);
        u32x4* op = (u32x4*)(MIX + (size_t)t * D_ + HW_ + h * 64);
#pragma unroll
        for (int c = 0; c < 8; ++c) { u32x4 w;
            w.x = pk2(ov[8 * c + 0] * rstd * p.attn_norm_g[8 * c + 0], ov[8 * c + 1] * rstd * p.attn_norm_g[8 * c + 1]);
            w.y = pk2(ov[8 * c + 2] * rstd * p.attn_norm_g[8 * c + 2], ov[8 * c + 3] * rstd * p.attn_norm_g[8 * c + 3]);
            w.z = pk2(ov[8 * c + 4] * rstd * p.attn_norm_g[8 * c + 4], ov[8 * c + 5] * rstd * p.attn_norm_g[8 * c + 5]);
            w.w = pk2(ov[8 * c + 6] * rstd * p.attn_norm_g[8 * c + 6], ov[8 * c + 7] * rstd * p.attn_norm_g[8 * c + 7]);
            op[c] = w; }
    }
}


typedef short s16x4 __attribute__((ext_vector_type(4)));
constexpr size_t OFF_UT = OFF_U;
constexpr size_t OFF_MLIST = OFF_X;
constexpr size_t OFF_LP = OFF_X + 17 * MBy;
constexpr size_t OFF_MP = OFF_LP + 2 * MBy;
constexpr int MLIST_STRIDE = 516096;

__device__ __forceinline__ void hgrn_cumsum(const bf16_t* lfcol, int sq, int k, LAS float* qs, float (&lf)[16], float (&bb)[16], float (&rq)[5]) {
    float run = 0.f;
#pragma unroll
    for (int i = 0; i < 16; ++i) { lf[i] = bf2f(lfcol[(size_t)(16 * sq + i) * NPROJ]); run += lf[i]; bb[i] = run; }
    qs[sq * 128 + k] = run;
    __syncthreads();
    const float q0 = qs[k], q1 = qs[128 + k], q2 = qs[256 + k], q3 = qs[384 + k];
    rq[0] = 0.f; rq[1] = q0; rq[2] = q0 + q1; rq[3] = q0 + q1 + q2; rq[4] = q0 + q1 + q2 + q3;
    const float off = sq == 0 ? 0.f : (sq == 1 ? rq[1] : (sq == 2 ? rq[2] : rq[3]));
#pragma unroll
    for (int i = 0; i < 16; ++i) bb[i] += off;
}
__device__ __forceinline__ void st16_bf16(LAS bf16_t* dst, const float (&v)[16]) {
    u32x4 a, b;
    a.x = pk2(v[0], v[1]); a.y = pk2(v[2], v[3]); a.z = pk2(v[4], v[5]); a.w = pk2(v[6], v[7]);
    b.x = pk2(v[8], v[9]); b.y = pk2(v[10], v[11]); b.z = pk2(v[12], v[13]); b.w = pk2(v[14], v[15]);
    *(LAS u32x4*)dst = a; *(LAS u32x4*)(dst + 8) = b;
}

__device__ __forceinline__ void hgrn_local_unit(const Params& p, int unit, LAS unsigned char* lds) {
    const int tid = tidx(), k = tid & 127, sq = tid >> 7, lane = tid & 63, w = tid >> 6, fr = lane & 15, g = lane >> 4;
    const int c = unit & 255, bh = unit >> 8, h = bh % NHH, b = bh / NHH;
    const bf16_t* PROJ = (const bf16_t*)(p.ws + OFF_PROJ);
    const bf16_t* rowb = PROJ + (size_t)(b * S_ + c * 64) * NPROJ + h * 128 + k;
    LAS float* qs = (LAS float*)lds;
    LAS bf16_t* KT = (LAS bf16_t*)(lds + 2048);
    LAS bf16_t* VT = KT + 128 * 72;
    float lf[16], bb[16], rq[5];
    hgrn_cumsum(rowb + C_HF, sq, k, qs, lf, bb, rq);
    const float bl = rq[4];
    float tmp[16];
#pragma unroll
    for (int i = 0; i < 16; ++i) tmp[i] = (1.f - __expf(lf[i])) * __expf(bl - bb[i]);
    st16_bf16(KT + k * 72 + 16 * sq, tmp);
#pragma unroll
    for (int i = 0; i < 16; ++i) tmp[i] = bf2f(rowb[(size_t)(16 * sq + i) * NPROJ + C_HI]);
    st16_bf16(VT + k * 72 + 16 * sq, tmp);
    if (sq == 0) ((float*)(p.ws + OFF_DEC))[unit * 128 + k] = __expf(bl);
    __syncthreads();
    const bf16x8 a0 = *(const LAS bf16x8*)(KT + (16 * w + fr) * 72 + 8 * g), a1 = *(const LAS bf16x8*)(KT + (16 * w + fr) * 72 + 32 + 8 * g);
    bf16_t* UT = (bf16_t*)(p.ws + OFF_UT) + (size_t)unit * 16384;
#pragma unroll
    for (int n = 0; n < 8; ++n) {
        const bf16x8 b0 = *(const LAS bf16x8*)(VT + (16 * n + fr) * 72 + 8 * g), b1 = *(const LAS bf16x8*)(VT + (16 * n + fr) * 72 + 32 + 8 * g);
        f32x4 acc = (f32x4){0.f, 0.f, 0.f, 0.f};
        acc = __builtin_amdgcn_mfma_f32_16x16x32_bf16(a0, b0, acc, 0, 0, 0);
        acc = __builtin_amdgcn_mfma_f32_16x16x32_bf16(a1, b1, acc, 0, 0, 0);
        uint2 o; o.x = pk2(acc[0], acc[1]); o.y = pk2(acc[2], acc[3]);
        *(uint2*)(UT + (16 * n + fr) * 128 + 16 * w + 4 * g) = o;
    }
    __syncthreads();
}

__device__ __forceinline__ void hgrn_scan(const Params& p, int bid, int nb, bool dummy = false) {
    bf16_t* UT = (bf16_t*)(p.ws + (dummy ? OFF_OP : OFF_UT));
    const float* DEC = (const float*)(p.ws + OFF_DEC);
    const int per_blk = (NB_ * NHH * 8192 + nb - 1) / nb;
    for (int idx = bid * per_blk + tidx(); idx < NB_ * NHH * 8192 && idx < (bid + 1) * per_blk; idx += NTHREADS) {
        const int bh = idx >> 13, r = idx & 8191;
        bf16_t* base = UT + (size_t)bh * 256 * 16384 + r * 2;
        const float* db = DEC + (size_t)bh * 256 * 128 + (r & 63) * 2;
        float s0 = 0.f, s1 = 0.f;
        for (int c0 = 0; c0 < 256; c0 += 16) {
            unsigned u[16]; float2 d[16];
#pragma unroll
            for (int i = 0; i < 16; ++i) { u[i] = *(const unsigned*)(base + (size_t)(c0 + i) * 16384); d[i] = *(const float2*)(db + (c0 + i) * 128); }
#pragma unroll
            for (int i = 0; i < 16; ++i) {
                *(unsigned*)(base + (size_t)(c0 + i) * 16384) = pk2(s0, s1);
                s0 = d[i].x * s0 + __uint_as_float(u[i] << 16); s1 = d[i].y * s1 + __uint_as_float(u[i] & 0xffff0000u);
            }
        }
    }
}

__device__ __forceinline__ void hgrn_out_unit(const Params& p, int unit, LAS unsigned char* lds) {
    const int tid = tidx(), k = tid & 127, sq = tid >> 7, lane = tid & 63, w = tid >> 6, fr = lane & 15, g = lane >> 4;
    const int c = unit & 255, bh = unit >> 8, h = bh % NHH, b = bh / NHH;
    const bf16_t* PROJ = (const bf16_t*)(p.ws + OFF_PROJ);
    const size_t t0 = (size_t)b * S_ + c * 64;
    const bf16_t* rowb = PROJ + t0 * NPROJ + h * 128 + k;
    LAS float* qs = (LAS float*)lds;
    LAS float* ssum = (LAS float*)(lds + 2048);
    LAS bf16_t* Q0 = (LAS bf16_t*)(lds + 4096);
    LAS bf16_t* KS = Q0 + 64 * 136;
    LAS bf16_t* QV = KS + 64 * 136;
    LAS bf16_t* VT = QV + 10 * 16 * 136;
    LAS bf16_t* PL = VT + 128 * 72;
    const bf16_t* ST = (const bf16_t*)(p.ws + OFF_UT) + (size_t)unit * 16384 + (size_t)(16 * w + fr) * 128 + 8 * g;
    bf16x8 aS[4];
#pragma unroll
    for (int ks = 0; ks < 4; ++ks) aS[ks] = *(const bf16x8*)(ST + 32 * ks);
    float lf[16], bb[16], rq[5];
    hgrn_cumsum(rowb + C_HF, sq, k, qs, lf, bb, rq);
    {
        float qq[16];
#pragma unroll
        for (int i = 0; i < 16; ++i) qq[i] = bf2f(rowb[(size_t)(16 * sq + i) * NPROJ + C_HQ]);
        const float rI = sq == 0 ? rq[1] : (sq == 1 ? rq[2] : (sq == 2 ? rq[3] : rq[4]));
#pragma unroll
        for (int i = 0; i < 16; ++i) {
            Q0[(16 * sq + i) * 136 + k] = f2bf(qq[i] * __expf(bb[i]));
            KS[(16 * sq + i) * 136 + k] = f2bf((1.f - __expf(lf[i])) * __expf(rI - bb[i]));
        }
#pragma unroll
        for (int J = 0; J < 4; ++J) {
            if (J <= sq) {
                const int pair = (sq * (sq + 1)) / 2 + J;
#pragma unroll
                for (int i = 0; i < 16; ++i) QV[(pair * 16 + i) * 136 + k] = f2bf(qq[i] * __expf(bb[i] - rq[J + 1]));
            }
        }
        float tmp[16];
#pragma unroll
        for (int i = 0; i < 16; ++i) tmp[i] = bf2f(rowb[(size_t)(16 * sq + i) * NPROJ + C_HI]);
        st16_bf16(VT + k * 72 + 16 * sq, tmp);
    }
    __syncthreads();
#pragma unroll
    for (int rep = 0; rep < 2; ++rep) {
        const int id = w + 8 * rep, I = id >> 2, J = id & 3;
        f32x4 acc = (f32x4){0.f, 0.f, 0.f, 0.f};
        if (J <= I) {
            const int pair = (I * (I + 1)) / 2 + J;
#pragma unroll
            for (int ks = 0; ks < 4; ++ks) {
                const bf16x8 a = *(const LAS bf16x8*)(QV + (pair * 16 + fr) * 136 + 32 * ks + 8 * g);
                const bf16x8 bq = *(const LAS bf16x8*)(KS + (16 * J + fr) * 136 + 32 * ks + 8 * g);
                acc = __builtin_amdgcn_mfma_f32_16x16x32_bf16(a, bq, acc, 0, 0, 0);
            }
            if (I == J) {
#pragma unroll
                for (int j = 0; j < 4; ++j) if (fr > 4 * g + j) acc[j] = 0.f;
            }
        }
#pragma unroll
        for (int j = 0; j < 4; ++j) PL[(16 * I + 4 * g + j) * 72 + 16 * J + fr] = f2bf(acc[j]);
    }
    __syncthreads();
    const bf16x8 aV0 = *(const LAS bf16x8*)(VT + (16 * w + fr) * 72 + 8 * g), aV1 = *(const LAS bf16x8*)(VT + (16 * w + fr) * 72 + 32 + 8 * g);
    f32x4 o[4];
#pragma unroll
    for (int ti = 0; ti < 4; ++ti) {
        f32x4 acc = (f32x4){0.f, 0.f, 0.f, 0.f};
#pragma unroll
        for (int ks = 0; ks < 4; ++ks) { const bf16x8 bq = *(const LAS bf16x8*)(Q0 + (16 * ti + fr) * 136 + 32 * ks + 8 * g); acc = __builtin_amdgcn_mfma_f32_16x16x32_bf16(aS[ks], bq, acc, 0, 0, 0); }
        { const bf16x8 b0 = *(const LAS bf16x8*)(PL + (16 * ti + fr) * 72 + 8 * g), b1 = *(const LAS bf16x8*)(PL + (16 * ti + fr) * 72 + 32 + 8 * g);
          acc = __builtin_amdgcn_mfma_f32_16x16x32_bf16(aV0, b0, acc, 0, 0, 0); acc = __builtin_amdgcn_mfma_f32_16x16x32_bf16(aV1, b1, acc, 0, 0, 0); }
        o[ti] = acc;
        float ss = acc[0] * acc[0] + acc[1] * acc[1] + acc[2] * acc[2] + acc[3] * acc[3];
        ss += __shfl_xor(ss, 16); ss += __shfl_xor(ss, 32);
        if (g == 0) ssum[w * 64 + 16 * ti + fr] = ss;
    }
    __syncthreads();
    bf16_t* MIX = (bf16_t*)(p.ws + OFF_MIX);
    const f32x4 ng = *(const f32x4*)(p.hgrn_norm_g + 16 * w + 4 * g);
#pragma unroll
    for (int ti = 0; ti < 4; ++ti) {
        float tot = 0.f;
#pragma unroll
        for (int ww = 0; ww < 8; ++ww) tot += ssum[ww * 64 + 16 * ti + fr];
        const float rstd = rsqrtf(tot * (1.f / 128.f) + RMS_EPS);
        const size_t t = t0 + 16 * ti + fr;
        const uint2 gw = *(const uint2*)(PROJ + t * NPROJ + C_HG + h * 128 + 16 * w + 4 * g);
        uint2 ow;
        ow.x = pk2(o[ti][0] * rstd * ng[0] * __uint_as_float(gw.x << 16), o[ti][1] * rstd * ng[1] * __uint_as_float(gw.x & 0xffff0000u));
        ow.y = pk2(o[ti][2] * rstd * ng[2] * __uint_as_float(gw.y << 16), o[ti][3] * rstd * ng[3] * __uint_as_float(gw.y & 0xffff0000u));
        *(uint2*)(MIX + t * D_ + h * 128 + 16 * w + 4 * g) = ow;
    }
    __syncthreads();
}


#define TRRD(dst, addr, off) asm volatile("ds_read_b64_tr_b16 %0, %1 offset:%2" : "=&v"(dst) : "v"(addr), "i"(off) : "memory")
#define LGKM0() do { asm volatile("s_waitcnt lgkmcnt(0)" ::: "memory"); __builtin_amdgcn_sched_barrier(0); } while (0)
constexpr int HT_STRIDE = 136;
template <int NT_> struct HgRegs { u32x4 v[NT_][2]; };
template <int NT_>
__device__ __forceinline__ void hgrn_stage_load(const bf16_t* PROJ, size_t t0, const int (&col)[NT_], HgRegs<NT_>& rg) {
    const int tid = tidx();
#pragma unroll
    for (int i = 0; i < NT_; ++i)
#pragma unroll
        for (int r = 0; r < 2; ++r) { const int id = tid + NTHREADS * r, row = id >> 4, ch = id & 15; rg.v[i][r] = *(const u32x4*)(PROJ + (t0 + row) * NPROJ + col[i] + 8 * ch); }
}
template <int NT_>
__device__ __forceinline__ void hgrn_stage_store(LAS bf16_t* const (&tile)[NT_], const HgRegs<NT_>& rg) {
    const int tid = tidx();
#pragma unroll
    for (int i = 0; i < NT_; ++i)
#pragma unroll
        for (int r = 0; r < 2; ++r) { const int id = tid + NTHREADS * r, row = id >> 4, ch = id & 15; *(LAS u32x4*)(tile[i] + row * HT_STRIDE + 8 * ch) = rg.v[i][r]; }
}
__device__ __forceinline__ size_t hgrn_unit_t0(int unit, int& h) { const int c = unit & 255, bh = unit >> 8; h = bh % NHH; return (size_t)(bh / NHH) * S_ + c * 64; }
__device__ __forceinline__ void hgrn_cumsum_mfma(LAS bf16_t* LF, int w, int fr, int g, f32x4 (&bT)[4]) {
    const unsigned base = (unsigned)(size_t)LF + (unsigned)((4 * g + (fr >> 2)) * (HT_STRIDE * 2) + (16 * w + 4 * (fr & 3)) * 2);
    s16x4 lo0, hi0, lo1, hi1;
    TRRD(lo0, base, 0); TRRD(hi0, base, 16 * HT_STRIDE * 2); TRRD(lo1, base, 32 * HT_STRIDE * 2); TRRD(hi1, base, 48 * HT_STRIDE * 2);
    LGKM0();
    const bf16x8 a0 = (bf16x8){lo0[0], lo0[1], lo0[2], lo0[3], hi0[0], hi0[1], hi0[2], hi0[3]};
    const bf16x8 a1 = (bf16x8){lo1[0], lo1[1], lo1[2], lo1[3], hi1[0], hi1[1], hi1[2], hi1[3]};
#pragma unroll
    for (int ti = 0; ti < 4; ++ti) {
        const int t = 16 * ti + fr;
        bf16x8 b0, b1;
#pragma unroll
        for (int e = 0; e < 4; ++e) {
            b0[e] = (4 * g + e <= t) ? (short)0x3F80 : (short)0;          b0[4 + e] = (16 + 4 * g + e <= t) ? (short)0x3F80 : (short)0;
            b1[e] = (32 + 4 * g + e <= t) ? (short)0x3F80 : (short)0;     b1[4 + e] = (48 + 4 * g + e <= t) ? (short)0x3F80 : (short)0;
        }
        f32x4 acc = (f32x4){0.f, 0.f, 0.f, 0.f};
        acc = __builtin_amdgcn_mfma_f32_16x16x32_bf16(a0, b0, acc, 0, 0, 0);
        acc = __builtin_amdgcn_mfma_f32_16x16x32_bf16(a1, b1, acc, 0, 0, 0);
        bT[ti] = acc;
    }
}
__device__ __forceinline__ f32x4 ld4bf(const LAS bf16_t* p) { const u32x2 v = *(const LAS u32x2*)p; return (f32x4){__uint_as_float(v.x << 16), __uint_as_float(v.x & 0xffff0000u), __uint_as_float(v.y << 16), __uint_as_float(v.y & 0xffff0000u)}; }
__device__ __forceinline__ void st4bf(LAS bf16_t* p, float a, float b, float c, float d) { u32x2 v; v.x = pk2(a, b); v.y = pk2(c, d); *(LAS u32x2*)p = v; }

__device__ __forceinline__ void hgrn_local_load(const Params& p, int unit, HgRegs<2>& rg) {
    int h; const size_t t0 = hgrn_unit_t0(unit, h);
    const int col[2] = {C_HF + h * 128, C_HI + h * 128};
    hgrn_stage_load<2>((const bf16_t*)(p.ws + OFF_PROJ), t0, col, rg);
}
__device__ __forceinline__ void hgrn_local_unit2(const Params& p, int unit, int next_unit, HgRegs<2>& rg, LAS unsigned char* lds) {
    const int tid = tidx(), lane = tid & 63, w = tid >> 6, fr = lane & 15, g = lane >> 4;
    LAS bf16_t* LF = (LAS bf16_t*)lds;
    LAS bf16_t* VV = LF + 64 * HT_STRIDE;
    __syncthreads();
    { LAS bf16_t* const tl[2] = {LF, VV}; hgrn_stage_store<2>(tl, rg); }
    if (next_unit >= 0) hgrn_local_load(p, next_unit, rg);
    __syncthreads();
    f32x4 bT[4];
    hgrn_cumsum_mfma(LF, w, fr, g, bT);
    f32x4 bl;
#pragma unroll
    for (int j = 0; j < 4; ++j) bl[j] = __shfl(bT[3][j], (lane & 48) | 15);
#pragma unroll
    for (int ti = 0; ti < 4; ++ti) {
        LAS bf16_t* pp = LF + (16 * ti + fr) * HT_STRIDE + 16 * w + 4 * g;
        const f32x4 lf = ld4bf(pp);
        st4bf(pp, (1.f - __expf(lf[0])) * __expf(bl[0] - bT[ti][0]), (1.f - __expf(lf[1])) * __expf(bl[1] - bT[ti][1]),
                  (1.f - __expf(lf[2])) * __expf(bl[2] - bT[ti][2]), (1.f - __expf(lf[3])) * __expf(bl[3] - bT[ti][3]));
    }
    if (fr == 0) *(f32x4*)((float*)(p.ws + OFF_DEC) + unit * 128 + 16 * w + 4 * g) = (f32x4){__expf(bl[0]), __expf(bl[1]), __expf(bl[2]), __expf(bl[3])};
    const unsigned rowoff = (unsigned)((4 * g + (fr >> 2)) * (HT_STRIDE * 2) + 4 * (fr & 3) * 2);
    const unsigned abase = (unsigned)(size_t)LF + rowoff + (unsigned)(16 * w * 2);
    s16x4 lo0, hi0, lo1, hi1;
    TRRD(lo0, abase, 0); TRRD(hi0, abase, 16 * HT_STRIDE * 2); TRRD(lo1, abase, 32 * HT_STRIDE * 2); TRRD(hi1, abase, 48 * HT_STRIDE * 2);
    LGKM0();
    const bf16x8 a0 = (bf16x8){lo0[0], lo0[1], lo0[2], lo0[3], hi0[0], hi0[1], hi0[2], hi0[3]};
    const bf16x8 a1 = (bf16x8){lo1[0], lo1[1], lo1[2], lo1[3], hi1[0], hi1[1], hi1[2], hi1[3]};
    bf16_t* UT = (bf16_t*)(p.ws + OFF_UT) + (size_t)unit * 16384;
    const unsigned vbase = (unsigned)(size_t)VV + rowoff;
#pragma unroll
    for (int n = 0; n < 8; ++n) {
        s16x4 l0, h0, l1, h1;
        TRRD(l0, vbase, n * 32); TRRD(h0, vbase, n * 32 + 16 * HT_STRIDE * 2); TRRD(l1, vbase, n * 32 + 32 * HT_STRIDE * 2); TRRD(h1, vbase, n * 32 + 48 * HT_STRIDE * 2);
        LGKM0();
        const bf16x8 b0 = (bf16x8){l0[0], l0[1], l0[2], l0[3], h0[0], h0[1], h0[2], h0[3]};
        const bf16x8 b1 = (bf16x8){l1[0], l1[1], l1[2], l1[3], h1[0], h1[1], h1[2], h1[3]};
        f32x4 acc = (f32x4){0.f, 0.f, 0.f, 0.f};
        acc = __builtin_amdgcn_mfma_f32_16x16x32_bf16(a0, b0, acc, 0, 0, 0);
        acc = __builtin_amdgcn_mfma_f32_16x16x32_bf16(a1, b1, acc, 0, 0, 0);
        uint2 o; o.x = pk2(acc[0], acc[1]); o.y = pk2(acc[2], acc[3]);
        *(uint2*)(UT + (16 * n + fr) * 128 + 16 * w + 4 * g) = o;
    }
}

struct HgOutRegs { HgRegs<3> t; bf16x8 aS[4]; uint2 gw[4]; };
__device__ __forceinline__ void hgrn_out_load(const Params& p, int unit, HgOutRegs& rg) {
    const int lane = tidx() & 63, w = tidx() >> 6, fr = lane & 15, g = lane >> 4;
    int h; const size_t t0 = hgrn_unit_t0(unit, h);
    const bf16_t* ST = (const bf16_t*)(p.ws + OFF_UT) + (size_t)unit * 16384 + (size_t)(16 * w + fr) * 128 + 8 * g;
#pragma unroll
    for (int ks = 0; ks < 4; ++ks) rg.aS[ks] = *(const bf16x8*)(ST + 32 * ks);
    const int col[3] = {C_HF + h * 128, C_HQ + h * 128, C_HI + h * 128};
    hgrn_stage_load<3>((const bf16_t*)(p.ws + OFF_PROJ), t0, col, rg.t);
#pragma unroll
    for (int ti = 0; ti < 4; ++ti) rg.gw[ti] = *(const uint2*)((const bf16_t*)(p.ws + OFF_PROJ) + (t0 + 16 * ti + fr) * NPROJ + C_HG + h * 128 + 16 * w + 4 * g);
}
__device__ __forceinline__ void hgrn_out_unit2(const Params& p, int unit, int next_unit, HgOutRegs& rg, LAS unsigned char* lds) {
    const int tid = tidx(), lane = tid & 63, w = tid >> 6, fr = lane & 15, g = lane >> 4;
    int h; const size_t t0 = hgrn_unit_t0(unit, h);
    const bf16_t* PROJ = (const bf16_t*)(p.ws + OFF_PROJ);
    LAS float* ssum = (LAS float*)lds;
    LAS bf16_t* LF = (LAS bf16_t*)(lds + 2048);
    LAS bf16_t* QQ = LF + 64 * HT_STRIDE;
    LAS bf16_t* VV = QQ + 64 * HT_STRIDE;
    LAS bf16_t* QV = VV + 64 * HT_STRIDE;
    LAS bf16_t* PL = QV + 10 * 16 * HT_STRIDE;
    bf16x8 aS[4]; uint2 gwv[4];
#pragma unroll
    for (int ks = 0; ks < 4; ++ks) { aS[ks] = rg.aS[ks]; gwv[ks] = rg.gw[ks]; }
    __syncthreads();
    { LAS bf16_t* const tl[3] = {LF, QQ, VV}; hgrn_stage_store<3>(tl, rg.t); }
    if (next_unit >= 0) hgrn_out_load(p, next_unit, rg);
    __syncthreads();
    f32x4 bT[4];
    hgrn_cumsum_mfma(LF, w, fr, g, bT);
    f32x4 rJ[4];
#pragma unroll
    for (int J = 0; J < 4; ++J)
#pragma unroll
        for (int j = 0; j < 4; ++j) rJ[J][j] = __shfl(bT[J][j], (lane & 48) | 15);
#pragma unroll
    for (int ti = 0; ti < 4; ++ti) {
        const int co = (16 * ti + fr) * HT_STRIDE + 16 * w + 4 * g;
        const f32x4 lf = ld4bf(LF + co), qq = ld4bf(QQ + co);
        st4bf(QQ + co, qq[0] * __expf(bT[ti][0]), qq[1] * __expf(bT[ti][1]), qq[2] * __expf(bT[ti][2]), qq[3] * __expf(bT[ti][3]));
        st4bf(LF + co, (1.f - __expf(lf[0])) * __expf(rJ[ti][0] - bT[ti][0]), (1.f - __expf(lf[1])) * __expf(rJ[ti][1] - bT[ti][1]),
                       (1.f - __expf(lf[2])) * __expf(rJ[ti][2] - bT[ti][2]), (1.f - __expf(lf[3])) * __expf(rJ[ti][3] - bT[ti][3]));
#pragma unroll
        for (int J = 0; J < 4; ++J) {
            if (J <= ti) {
                const int pair = (ti * (ti + 1)) / 2 + J;
                st4bf(QV + (pair * 16 + fr) * HT_STRIDE + 16 * w + 4 * g, qq[0] * __expf(bT[ti][0] - rJ[J][0]), qq[1] * __expf(bT[ti][1] - rJ[J][1]),
                      qq[2] * __expf(bT[ti][2] - rJ[J][2]), qq[3] * __expf(bT[ti][3] - rJ[J][3]));
            }
        }
    }
    __syncthreads();
#pragma unroll
    for (int rep = 0; rep < 2; ++rep) {
        const int id = w + 8 * rep, I = id >> 2, J = id & 3;
        f32x4 acc = (f32x4){0.f, 0.f, 0.f, 0.f};
        if (J <= I) {
            const int pair = (I * (I + 1)) / 2 + J;
#pragma unroll
            for (int ks = 0; ks < 4; ++ks) {
                const bf16x8 a = *(const LAS bf16x8*)(QV + (pair * 16 + fr) * HT_STRIDE + 32 * ks + 8 * g);
                const bf16x8 bq = *(const LAS bf16x8*)(LF + (16 * J + fr) * HT_STRIDE + 32 * ks + 8 * g);
                acc = __builtin_amdgcn_mfma_f32_16x16x32_bf16(a, bq, acc, 0, 0, 0);
            }
            if (I == J) {
#pragma unroll
                for (int j = 0; j < 4; ++j) if (fr > 4 * g + j) acc[j] = 0.f;
            }
        }
#pragma unroll
        for (int j = 0; j < 4; ++j) PL[(16 * I + 4 * g + j) * 72 + 16 * J + fr] = f2bf(acc[j]);
    }
    __syncthreads();
    const unsigned vbase = (unsigned)(size_t)VV + (unsigned)((4 * g + (fr >> 2)) * (HT_STRIDE * 2) + (16 * w + 4 * (fr & 3)) * 2);
    s16x4 l0, h0, l1, h1;
    TRRD(l0, vbase, 0); TRRD(h0, vbase, 16 * HT_STRIDE * 2); TRRD(l1, vbase, 32 * HT_STRIDE * 2); TRRD(h1, vbase, 48 * HT_STRIDE * 2);
    LGKM0();
    const bf16x8 aV0 = (bf16x8){l0[0], l0[1], l0[2], l0[3], h0[0], h0[1], h0[2], h0[3]};
    const bf16x8 aV1 = (bf16x8){l1[0], l1[1], l1[2], l1[3], h1[0], h1[1], h1[2], h1[3]};
    f32x4 o[4];
#pragma unroll
    for (int ti = 0; ti < 4; ++ti) {
        f32x4 acc = (f32x4){0.f, 0.f, 0.f, 0.f};
#pragma unroll
        for (int ks = 0; ks < 4; ++ks) { const bf16x8 bq = *(const LAS bf16x8*)(QQ + (16 * ti + fr) * HT_STRIDE + 32 * ks + 8 * g); acc = __builtin_amdgcn_mfma_f32_16x16x32_bf16(aS[ks], bq, acc, 0, 0, 0); }
        {
            const LAS bf16_t* pr = PL + (16 * ti + fr) * 72 + 4 * g;
            const u32x2 x0 = *(const LAS u32x2*)(pr), x1 = *(const LAS u32x2*)(pr + 16), x2 = *(const LAS u32x2*)(pr + 32), x3 = *(const LAS u32x2*)(pr + 48);
            const bf16x8 b0 = __builtin_bit_cast(bf16x8, (u32x4){x0.x, x0.y, x1.x, x1.y}), b1 = __builtin_bit_cast(bf16x8, (u32x4){x2.x, x2.y, x3.x, x3.y});
            acc = __builtin_amdgcn_mfma_f32_16x16x32_bf16(aV0, b0, acc, 0, 0, 0); acc = __builtin_amdgcn_mfma_f32_16x16x32_bf16(aV1, b1, acc, 0, 0, 0);
        }
        o[ti] = acc;
        float ss = acc[0] * acc[0] + acc[1] * acc[1] + acc[2] * acc[2] + acc[3] * acc[3];
        ss += __shfl_xor(ss, 16); ss += __shfl_xor(ss, 32);
        if (g == 0) ssum[w * 64 + 16 * ti + fr] = ss;
    }
    __syncthreads();
    bf16_t* MIX = (bf16_t*)(p.ws + OFF_MIX);
    const f32x4 ng = *(const f32x4*)(p.hgrn_norm_g + 16 * w + 4 * g);
#pragma unroll
    for (int ti = 0; ti < 4; ++ti) {
        float tot = 0.f;
#pragma unroll
        for (int ww = 0; ww < 8; ++ww) tot += ssum[ww * 64 + 16 * ti + fr];
        const float rstd = rsqrtf(tot * (1.f / 128.f) + RMS_EPS);
        const size_t t = t0 + 16 * ti + fr;
        const uint2 gw = gwv[ti];
        uint2 ow;
        ow.x = pk2(o[ti][0] * rstd * ng[0] * __uint_as_float(gw.x << 16), o[ti][1] * rstd * ng[1] * __uint_as_float(gw.x & 0xffff0000u));
        ow.y = pk2(o[ti][2] * rstd * ng[2] * __uint_as_float(gw.y << 16), o[ti][3] * rstd * ng[3] * __uint_as_float(gw.y & 0xffff0000u));
        *(uint2*)(MIX + t * D_ + h * 128 + 16 * w + 4 * g) = ow;
    }
}

__device__ __forceinline__ int moba_list_off(int j) { return 256 * (63 * j - (j * (j - 1)) / 2); }

__device__ __forceinline__ void moba_kmean(const Params& p, int bid, int nb, LAS unsigned char* lds) {
    const int tid = tidx(), d = tid & 63, kq = tid >> 6;
    const bf16_t* PROJ = (const bf16_t*)(p.ws + OFF_PROJ);
    LAS float* red = (LAS float*)lds;
    float* KM = (float*)(p.ws + OFF_KM);
    for (int u = bid; u < NB_ * AHN * 64; u += nb) {
        const int j = u & 63, h = (u >> 6) & 3, b = u >> 8;
        const bf16_t* kp = PROJ + (size_t)(b * S_ + j * 256 + kq * 32) * NPROJ + C_AK + h * 64 + d;
        float s = 0.f;
#pragma unroll 8
        for (int i = 0; i < 32; ++i) s += bf2f(kp[(size_t)i * NPROJ]);
        __syncthreads();
        red[kq * 64 + d] = s;
        __syncthreads();
        if (tid < 64) { float a = 0.f;
#pragma unroll
            for (int i = 0; i < 8; ++i) a += red[i * 64 + tid];
            KM[u * 64 + tid] = a * (1.f / 256.f); }
    }
}

__device__ __forceinline__ void moba_gating(const Params& p, int bid, int nb, LAS unsigned char* lds, bool dummy = false) {
    const int tid = tidx();
    const bf16_t* PROJ = (const bf16_t*)(p.ws + OFF_PROJ);
    const float* KM = (const float*)(p.ws + OFF_KM);
    LAS float* KML = (LAS float*)lds;
    LAS int* cntl = (LAS int*)(lds + 16384);
    LAS int* basel = cntl + 64;
    unsigned* gcnt = (unsigned*)(p.ws + OFF_CTL) + (dummy ? 1024 : 0);
    int* mlist = (int*)(p.ws + (dummy ? OFF_OP + 101 * MBy : OFF_MLIST));
    for (int item = bid; item < NB_ * AHN * 32; item += nb) {
        const int bh = item >> 5, chunk = item & 31, b = bh >> 2, h = bh & 3;
        __syncthreads();
        for (int i = tid; i < 4096; i += NTHREADS) KML[i] = KM[bh * 4096 + i];
        if (tid < 64) cntl[tid] = 0;
        __syncthreads();
        const int q = chunk * 512 + tid, own = q >> 8;
        const size_t t = (size_t)b * S_ + q;
        float qv[64];
        {
            const u32x4* qp = (const u32x4*)(PROJ + t * NPROJ + C_AQ + h * 64);
#pragma unroll
            for (int c = 0; c < 8; ++c) { const u32x4 wv = qp[c];
                qv[8 * c + 0] = __uint_as_float(wv.x << 16); qv[8 * c + 1] = __uint_as_float(wv.x & 0xffff0000u);
                qv[8 * c + 2] = __uint_as_float(wv.y << 16); qv[8 * c + 3] = __uint_as_float(wv.y & 0xffff0000u);
                qv[8 * c + 4] = __uint_as_float(wv.z << 16); qv[8 * c + 5] = __uint_as_float(wv.z & 0xffff0000u);
                qv[8 * c + 6] = __uint_as_float(wv.w << 16); qv[8 * c + 7] = __uint_as_float(wv.w & 0xffff0000u); }
        }
        float v0 = -INFINITY, v1 = -INFINITY, v2 = -INFINITY; int i0 = 0, i1 = 0, i2 = 0;
        for (int j = 0; j < own; ++j) {
            const LAS f32x4* km = (const LAS f32x4*)(KML + j * 64);
            float gt = 0.f;
#pragma unroll
            for (int c = 0; c < 16; ++c) { const f32x4 kv = km[c]; gt += qv[4 * c] * kv[0] + qv[4 * c + 1] * kv[1] + qv[4 * c + 2] * kv[2] + qv[4 * c + 3] * kv[3]; }
            if (gt > v0) { v2 = v1; i2 = i1; v1 = v0; i1 = i0; v0 = gt; i0 = j; }
            else if (gt > v1) { v2 = v1; i2 = i1; v1 = gt; i1 = j; }
            else if (gt > v2) { v2 = gt; i2 = j; }
        }
        const int nsel = own < 3 ? own : 3;
        int r0 = 0, r1 = 0, r2 = 0;
        if (nsel > 0) r0 = atomicAdd((int*)&cntl[i0], 1);
        if (nsel > 1) r1 = atomicAdd((int*)&cntl[i1], 1);
        if (nsel > 2) r2 = atomicAdd((int*)&cntl[i2], 1);
        __syncthreads();
        if (tid < 64) { const int cc = cntl[tid]; basel[tid] = cc ? (int)atomicAdd(&gcnt[bh * 64 + tid], (unsigned)cc) : 0; }
        __syncthreads();
        int* ml = mlist + (size_t)bh * MLIST_STRIDE;
        if (nsel > 0) ml[moba_list_off(i0) + basel[i0] + r0] = q;
        if (nsel > 1) ml[moba_list_off(i1) + basel[i1] + r1] = q | (1 << 14);
        if (nsel > 2) ml[moba_list_off(i2) + basel[i2] + r2] = q | (2 << 14);
    }
}


__device__ __forceinline__ void phase3b_ws(const Params& p, int bid, int nb, LAS unsigned char* lds) {
    const int tid = tidx(), lane = tid & 63, wave = tid >> 6;
    const bf16_t* PROJ = (const bf16_t*)(p.ws + OFF_PROJ);
    const float* KM = (const float*)(p.ws + OFF_KM);
    LAS float* KML = (LAS float*)lds;
    LAS int* wh = (LAS int*)(lds + 16384) + (wave & 3) * 128;
    unsigned* gcnt = (unsigned*)(p.ws + OFF_CTL);
    int* mlist = (int*)(p.ws + OFF_MLIST);
    bool scan_done = false;
    for (int item = bid; item < NB_ * AHN * 32 || !scan_done; item += nb) {
        const bool has_item = item < NB_ * AHN * 32;
        const int bh = has_item ? item >> 5 : 0, chunk = item & 31, b = bh >> 2, h = bh & 3;
        __syncthreads();
        if (has_item && tid < 256) { for (int i = tid; i < 4096; i += 256) KML[i] = KM[bh * 4096 + i]; }
        __syncthreads();
        if (wave < 4) {
            if (has_item) {
                for (int pass = 0; pass < 2; ++pass) {
                    const int q = chunk * 512 + (wave * 2 + pass) * 64 + lane, own = q >> 8;
                    const size_t t = (size_t)b * S_ + q;
                    float qv[64];
                    {
                        const u32x4* qp = (const u32x4*)(PROJ + t * NPROJ + C_AQ + h * 64);
#pragma unroll
                        for (int c = 0; c < 8; ++c) { const u32x4 wv = qp[c];
                            qv[8 * c + 0] = __uint_as_float(wv.x << 16); qv[8 * c + 1] = __uint_as_float(wv.x & 0xffff0000u);
                            qv[8 * c + 2] = __uint_as_float(wv.y << 16); qv[8 * c + 3] = __uint_as_float(wv.y & 0xffff0000u);
                            qv[8 * c + 4] = __uint_as_float(wv.z << 16); qv[8 * c + 5] = __uint_as_float(wv.z & 0xffff0000u);
                            qv[8 * c + 6] = __uint_as_float(wv.w << 16); qv[8 * c + 7] = __uint_as_float(wv.w & 0xffff0000u); }
                    }
                    float v0 = -INFINITY, v1 = -INFINITY, v2 = -INFINITY; int i0 = 0, i1 = 0, i2 = 0;
                    for (int j = 0; j < own; ++j) {
                        const LAS f32x4* km = (const LAS f32x4*)(KML + j * 64);
                        float gt = 0.f;
#pragma unroll
                        for (int c = 0; c < 16; ++c) { const f32x4 kv = km[c]; gt += qv[4 * c] * kv[0] + qv[4 * c + 1] * kv[1] + qv[4 * c + 2] * kv[2] + qv[4 * c + 3] * kv[3]; }
                        if (gt > v0) { v2 = v1; i2 = i1; v1 = v0; i1 = i0; v0 = gt; i0 = j; }
                        else if (gt > v1) { v2 = v1; i2 = i1; v1 = gt; i1 = j; }
                        else if (gt > v2) { v2 = gt; i2 = j; }
                    }
                    const int nsel = own < 3 ? own : 3;
                    wh[lane] = 0;
                    int r0 = 0, r1 = 0, r2 = 0;
                    if (nsel > 0) r0 = atomicAdd((int*)&wh[i0], 1);
                    if (nsel > 1) r1 = atomicAdd((int*)&wh[i1], 1);
                    if (nsel > 2) r2 = atomicAdd((int*)&wh[i2], 1);
                    const int cc = wh[lane];
                    wh[64 + lane] = cc ? (int)atomicAdd(&gcnt[bh * 64 + lane], (unsigned)cc) : 0;
                    int* ml = mlist + (size_t)bh * MLIST_STRIDE;
                    if (nsel > 0) ml[moba_list_off(i0) + wh[64 + i0] + r0] = q;
                    if (nsel > 1) ml[moba_list_off(i1) + wh[64 + i1] + r1] = q | (1 << 14);
                    if (nsel > 2) ml[moba_list_off(i2) + wh[64 + i2] + r2] = q | (2 << 14);
                }
            }
        } else if (!scan_done) {
            bf16_t* UT = (bf16_t*)(p.ws + OFF_UT);
            const float* DEC = (const float*)(p.ws + OFF_DEC);
            for (int idx = bid * 256 + (tid - 256); idx < NB_ * NHH * 8192; idx += nb * 256) {
                const int bh2 = idx >> 13, r = idx & 8191;
                bf16_t* base = UT + (size_t)bh2 * 256 * 16384 + r * 2;
                const float* db = DEC + (size_t)bh2 * 256 * 128 + (r & 63) * 2;
                float s0 = 0.f, s1 = 0.f;
                for (int c0 = 0; c0 < 256; c0 += 16) {
                    unsigned u[16]; float2 d[16];
#pragma unroll
                    for (int i = 0; i < 16; ++i) { u[i] = *(const unsigned*)(base + (size_t)(c0 + i) * 16384); d[i] = *(const float2*)(db + (c0 + i) * 128); }
#pragma unroll
                    for (int i = 0; i < 16; ++i) {
                        *(unsigned*)(base + (size_t)(c0 + i) * 16384) = pk2(s0, s1);
                        s0 = d[i].x * s0 + __uint_as_float(u[i] << 16); s1 = d[i].y * s1 + __uint_as_float(u[i] & 0xffff0000u);
                    }
                }
            }
        }
        scan_done = true;
    }
    __syncthreads();
}

struct MbDesc { int bh, j, kind, tix; };
struct MbQ { bf16x8 q0, q1; int q, slot, valid; };
__device__ __forceinline__ void moba_q_load(const Params& p, const MbDesc& d, MbQ& rg) {
    const int tid = tidx(), lane = tid & 63, w = tid >> 6, fr = lane & 15, g = lane >> 4;
    const int b = d.bh >> 2, h = d.bh & 3;
    const bf16_t* PROJ = (const bf16_t*)(p.ws + OFF_PROJ);
    if (d.kind == 0) {
        const int cnt = (int)((const unsigned*)(p.ws + OFF_CTL))[d.bh * 64 + d.j], li = d.tix * 128 + 16 * w + fr;
        rg.valid = li < cnt;
        const int entry = ((const int*)(p.ws + OFF_MLIST))[(size_t)d.bh * MLIST_STRIDE + moba_list_off(d.j) + (rg.valid ? li : d.tix * 128)];
        rg.q = entry & 16383; rg.slot = entry >> 14;
    } else { rg.q = 256 * d.j + 128 * d.tix + 16 * w + fr; rg.slot = 3; rg.valid = 1; }
    const bf16_t* qp = PROJ + ((size_t)b * S_ + rg.q) * NPROJ + C_AQ + h * 64;
    rg.q0 = *(const bf16x8*)(qp + 8 * g); rg.q1 = *(const bf16x8*)(qp + 32 + 8 * g);
}
__device__ __forceinline__ void moba_stage_kv(const Params& p, int bh, int j, LAS unsigned char* lds) {
    const int tid = tidx();
    const int b = bh >> 2, h = bh & 3;
    const bf16_t* PROJ = (const bf16_t*)(p.ws + OFF_PROJ);
    LAS bf16_t* KL = (LAS bf16_t*)lds;
    LAS bf16_t* VL = KL + 256 * 72;
    const bf16_t* kvbase = PROJ + (size_t)(b * S_ + j * 256) * NPROJ + h * 64;
    u32x4 kk[4], vv[4];
#pragma unroll
    for (int i = 0; i < 4; ++i) {
        const int id = tid + NTHREADS * i, key = id >> 3, ch = id & 7;
        kk[i] = *(const u32x4*)(kvbase + (size_t)key * NPROJ + C_AK + 8 * ch);
        vv[i] = *(const u32x4*)(kvbase + (size_t)key * NPROJ + C_AV + 8 * ch);
    }
#pragma unroll
    for (int i = 0; i < 4; ++i) {
        const int id = tid + NTHREADS * i, key = id >> 3, ch = id & 7;
        *(LAS u32x4*)(KL + key * 72 + 8 * ch) = kk[i]; *(LAS u32x4*)(VL + key * 72 + 8 * ch) = vv[i];
    }
}
__device__ __forceinline__ void moba_tile(const Params& p, const MbDesc& d, const MbQ& rq, LAS unsigned char* lds) {
    const int tid = tidx(), lane = tid & 63, w = tid >> 6, fr = lane & 15, g = lane >> 4;
    const int b = d.bh >> 2, h = d.bh & 3, kind = d.kind, tix = d.tix;
    LAS bf16_t* KL = (LAS bf16_t*)lds;
    LAS bf16_t* VL = KL + 256 * 72;
    const bf16x8 qf0 = rq.q0, qf1 = rq.q1; const int q = rq.q, slot = rq.slot; const bool valid = rq.valid != 0;
    const size_t t = (size_t)b * S_ + q;
    const int qloc = 128 * tix + 16 * w + fr;
    const int nkt = kind ? (((128 * tix + 16 * w + 15) >> 4) + 1) : 16;
    constexpr float SC = 0.125f * 1.4426950408889634f;
    f32x4 s[16];
#pragma unroll
    for (int kt = 0; kt < 16; ++kt) {
        if (kt < nkt) {
            const bf16x8 a0 = *(const LAS bf16x8*)(KL + (16 * kt + fr) * 72 + 8 * g), a1 = *(const LAS bf16x8*)(KL + (16 * kt + fr) * 72 + 32 + 8 * g);
            f32x4 acc = (f32x4){0.f, 0.f, 0.f, 0.f};
            acc = __builtin_amdgcn_mfma_f32_16x16x32_bf16(a0, qf0, acc, 0, 0, 0);
            acc = __builtin_amdgcn_mfma_f32_16x16x32_bf16(a1, qf1, acc, 0, 0, 0);
            s[kt] = acc;
            if (kind) {
#pragma unroll
                for (int jj = 0; jj < 4; ++jj) if (16 * kt + 4 * g + jj > qloc) s[kt][jj] = -INFINITY;
            }
        } else s[kt] = (f32x4){-INFINITY, -INFINITY, -INFINITY, -INFINITY};
    }
    float m = -INFINITY;
#pragma unroll
    for (int kt = 0; kt < 16; ++kt) m = fmaxf(m, fmaxf(fmaxf(s[kt][0], s[kt][1]), fmaxf(s[kt][2], s[kt][3])));
    m = fmaxf(m, __shfl_xor(m, 16)); m = fmaxf(m, __shfl_xor(m, 32));
    m *= SC;
    float l = 0.f;
#pragma unroll
    for (int kt = 0; kt < 16; ++kt) {
#pragma unroll
        for (int jj = 0; jj < 4; ++jj) { const float e = __builtin_amdgcn_exp2f(__builtin_fmaf(s[kt][jj], SC, -m)); s[kt][jj] = e; l += e; }
    }
    l += __shfl_xor(l, 16); l += __shfl_xor(l, 32);
    bf16x8 pfr[8];
#pragma unroll
    for (int ks = 0; ks < 8; ++ks) {
        u32x4 wv; wv.x = pk2(s[2 * ks][0], s[2 * ks][1]); wv.y = pk2(s[2 * ks][2], s[2 * ks][3]); wv.z = pk2(s[2 * ks + 1][0], s[2 * ks + 1][1]); wv.w = pk2(s[2 * ks + 1][2], s[2 * ks + 1][3]);
        pfr[ks] = __builtin_bit_cast(bf16x8, wv);
    }
    const unsigned vb = (unsigned)(size_t)VL + (unsigned)((4 * g + (fr >> 2)) * 144 + (fr & 3) * 8);
    bf16_t* OP = (bf16_t*)(p.ws + OFF_OP) + ((size_t)slot * T_ + t) * 256 + h * 64;
#pragma unroll
    for (int dt = 0; dt < 4; ++dt) {
        f32x4 acc = (f32x4){0.f, 0.f, 0.f, 0.f};
#pragma unroll
        for (int kh = 0; kh < 2; ++kh) {
            s16x4 lo[4], hi[4];
#pragma unroll
            for (int k4 = 0; k4 < 4; ++k4) {
                asm volatile("ds_read_b64_tr_b16 %0, %1 offset:%2" : "=&v"(lo[k4]) : "v"(vb), "i"((kh * 4 + k4) * 4608 + dt * 32) : "memory");
                asm volatile("ds_read_b64_tr_b16 %0, %1 offset:%2" : "=&v"(hi[k4]) : "v"(vb), "i"((kh * 4 + k4) * 4608 + 2304 + dt * 32) : "memory");
            }
            asm volatile("s_waitcnt lgkmcnt(0)" ::: "memory"); __builtin_amdgcn_sched_barrier(0);
#pragma unroll
            for (int k4 = 0; k4 < 4; ++k4) {
                const int ks = kh * 4 + k4;
                if (2 * ks < nkt) {
                    const bf16x8 va = (bf16x8){lo[k4][0], lo[k4][1], lo[k4][2], lo[k4][3], hi[k4][0], hi[k4][1], hi[k4][2], hi[k4][3]};
                    acc = __builtin_amdgcn_mfma_f32_16x16x32_bf16(va, pfr[ks], acc, 0, 0, 0);
                }
            }
        }
        if (valid) { uint2 ow; ow.x = pk2(acc[0], acc[1]); ow.y = pk2(acc[2], acc[3]); *(uint2*)(OP + 16 * dt + 4 * g) = ow; }
    }
    if (valid && g == 0) {
        ((float*)(p.ws + OFF_LP))[((size_t)slot * T_ + t) * 4 + h] = l;
        ((float*)(p.ws + OFF_MP))[((size_t)slot * T_ + t) * 4 + h] = m;
    }
}

__device__ __forceinline__ void moba_tiles(const Params& p, int bid, int nb, LAS unsigned char* lds) {
    const int tid = tidx();
    LAS int* pf = (LAS int*)(lds + 73728);
    const unsigned* gcnt = (const unsigned*)(p.ws + OFF_CTL);
    __syncthreads();
    { LAS int* sc = pf + 1; sc[tid] = ((int)gcnt[tid] + 127) / 128 + 2; __syncthreads();
      for (int o = 1; o < 512; o <<= 1) { const int a = (tid >= o) ? sc[tid - o] : 0; __syncthreads(); sc[tid] += a; __syncthreads(); }
      if (tid == 0) pf[0] = 0;
      __syncthreads(); }
    const int total = pf[512];
    const int t0 = (int)(((long)total * bid) / nb), t1 = (int)(((long)total * (bid + 1)) / nb);
    if (t0 < t1) {
        int gi; { int lo = 0, hi = 512; while (hi - lo > 1) { const int mid = (lo + hi) >> 1; if (pf[mid] <= t0) lo = mid; else hi = mid; } gi = lo; }
        int local = t0 - pf[gi], gtiles = pf[gi + 1] - pf[gi];
        MbDesc d; d.bh = gi >> 6; d.j = gi & 63; d.kind = local < gtiles - 2 ? 0 : 1; d.tix = local < gtiles - 2 ? local : local - (gtiles - 2);
        MbQ rq; moba_q_load(p, d, rq);
        int staged = -1;
        for (int T = t0; T < t1; ++T) {
            if (gi != staged) { __syncthreads(); moba_stage_kv(p, gi >> 6, gi & 63, lds); __syncthreads(); staged = gi; }
            MbDesc dn = d; MbQ rn = rq; int gin = gi, localn = local + 1, gtn = gtiles;
            if (localn >= gtn) { ++gin; localn = 0; gtn = (gin < 512) ? pf[gin + 1] - pf[gin] : 2; }
            const bool has_next = (T + 1 < t1);
            if (has_next) { dn.bh = gin >> 6; dn.j = gin & 63; dn.kind = localn < gtn - 2 ? 0 : 1; dn.tix = localn < gtn - 2 ? localn : localn - (gtn - 2); moba_q_load(p, dn, rn); }
            moba_tile(p, d, rq, lds);
            d = dn; rq = rn; gi = gin; local = localn; gtiles = gtn;
        }
    }
    __syncthreads();
}

__device__ __forceinline__ void moba_combine(const Params& p, int bid, int nb) {
    const int lane = tidx() & 63, w = tidx() >> 6, h = lane >> 4, d0 = (lane & 15) * 4;
    const bf16_t* OP = (const bf16_t*)(p.ws + OFF_OP);
    const float* LP = (const float*)(p.ws + OFF_LP);
    const float* MP = (const float*)(p.ws + OFF_MP);
    bf16_t* MIX = (bf16_t*)(p.ws + OFF_MIX);
    const f32x4 ng = *(const f32x4*)(p.attn_norm_g + d0);
    for (int t = bid * NWAVES + w; t < T_; t += nb * NWAVES) {
        const int own = (t & (S_ - 1)) >> 8, nsel = own < 3 ? own : 3;
        float ms[4], ls[4];
#pragma unroll
        for (int sl = 0; sl < 4; ++sl) { const bool on = (sl == 3) || (sl < nsel); ms[sl] = on ? MP[((size_t)sl * T_ + t) * 4 + h] : -INFINITY; ls[sl] = on ? LP[((size_t)sl * T_ + t) * 4 + h] : 0.f; }
        const float mx = fmaxf(fmaxf(ms[0], ms[1]), fmaxf(ms[2], ms[3]));
        float o0 = 0.f, o1 = 0.f, o2 = 0.f, o3 = 0.f, l = 0.f;
#pragma unroll
        for (int sl = 0; sl < 4; ++sl) {
            const bool on = (sl == 3) || (sl < nsel);
            if (on) { const float wg = __builtin_amdgcn_exp2f(ms[sl] - mx); l += wg * ls[sl];
                const uint2 ov = *(const uint2*)(OP + ((size_t)sl * T_ + t) * 256 + h * 64 + d0);
                o0 += wg * __uint_as_float(ov.x << 16); o1 += wg * __uint_as_float(ov.x & 0xffff0000u); o2 += wg * __uint_as_float(ov.y << 16); o3 += wg * __uint_as_float(ov.y & 0xffff0000u); }
        }
        const float inv = 1.f / l; o0 *= inv; o1 *= inv; o2 *= inv; o3 *= inv;
        float ss = o0 * o0 + o1 * o1 + o2 * o2 + o3 * o3;
        ss += __shfl_xor(ss, 1); ss += __shfl_xor(ss, 2); ss += __shfl_xor(ss, 4); ss += __shfl_xor(ss, 8);
        const float rstd = rsqrtf(ss * (1.f / 64.f) + RMS_EPS);
        uint2 ow; ow.x = pk2(o0 * rstd * ng[0], o1 * rstd * ng[1]); ow.y = pk2(o2 * rstd * ng[2], o3 * rstd * ng[3]);
        *(uint2*)(MIX + (size_t)t * D_ + HW_ + h * 64 + d0) = ow;
    }
}

__device__ __forceinline__ void phase5(const Params& p, int bid, int nb) {
    const int lane = tidx() & 63, wave = tidx() >> 6, lr = lane & 15, g = lane >> 4;
    const bf16_t* MIX = (const bf16_t*)(p.ws + OFF_MIX);
    const bf16_t* WT = (const bf16_t*)(p.ws + OFF_WOUT);
    const float* mod = (const float*)(p.ws + OFF_MOD);
    constexpr int NMT = T_ / 128, NNT = D_ / 64;
    for (int u = bid; u < NMT * NNT; u += nb) {
        const int mt = u / NNT, nt = u % NNT;
        const int row0 = mt * 128 + wave * 16, col0 = nt * 64;
        const bf16_t* arow = MIX + (size_t)(row0 + lr) * D_;
        const bf16_t* bcol[4];
#pragma unroll
        for (int n = 0; n < 4; ++n) bcol[n] = WT + (size_t)(col0 + 16 * n + lr) * D_;
        f32x4 acc[4];
        wave_gemm<4>(arow, bcol, D_, acc);
        const int b = row0 / S_;
#pragma unroll
        for (int n = 0; n < 4; ++n) {
            const int c = col0 + 16 * n + lr;
            const float g1 = mod[b * NMOD + 2 * D_ + c];
#pragma unroll
            for (int j = 0; j < 4; ++j) {
                const int t = row0 + 4 * g + j;
                p.out[(size_t)t * D_ + c] = p.x[(size_t)t * D_ + c] + g1 * acc[n][j];
            }
        }
    }
}

__device__ __forceinline__ void phase6(const Params& p, int bid, int nb) {
    const int lane = tidx() & 63, wave = tidx() >> 6;
    const float* mod = (const float*)(p.ws + OFF_MOD);
    const float* wrt = (const float*)(p.ws + OFF_WRT);
    bf16_t* H2 = (bf16_t*)(p.ws + OFF_H);
    unsigned* ecnt = (unsigned*)(p.ws + OFF_CTL) + CW_ECNT;
    int* elist = (int*)(p.ws + OFF_ELIST);
    float* gate = (float*)(p.ws + OFF_GATE);
    for (int t = bid * NWAVES + wave; t < T_; t += nb * NWAVES) {
        const int b = t / S_;
        const f32x4* xr = (const f32x4*)(p.out + (size_t)t * D_) + lane;
        f32x4 v[4]; float s = 0.f;
#pragma unroll
        for (int j = 0; j < 4; ++j) { v[j] = xr[64 * j]; s += v[j].x * v[j].x + v[j].y * v[j].y + v[j].z * v[j].z + v[j].w * v[j].w; }
        const float rstd = rsqrtf(wave_sum(s) * (1.f / D_) + RMS_EPS);
        const float* shift = mod + b * NMOD + 3 * D_, *scale = mod + b * NMOD + 4 * D_;
#pragma unroll
        for (int j = 0; j < 4; ++j) {
            const int k = 4 * lane + 256 * j;
            const f32x4 g = *(const f32x4*)(p.norm2_g + k), sc = *(const f32x4*)(scale + k), sh = *(const f32x4*)(shift + k);
            v[j].x = v[j].x * rstd * g.x * (1.f + sc.x) + sh.x; v[j].y = v[j].y * rstd * g.y * (1.f + sc.y) + sh.y;
            v[j].z = v[j].z * rstd * g.z * (1.f + sc.z) + sh.z; v[j].w = v[j].w * rstd * g.w * (1.f + sc.w) + sh.w;
            uint2 w; w.x = pk2(v[j].x, v[j].y); w.y = pk2(v[j].z, v[j].w);
            *(uint2*)(H2 + (size_t)t * D_ + k) = w;
        }
        float bv[4] = {-INFINITY, -INFINITY, -INFINITY, -INFINITY}; int bi[4] = {0, 0, 0, 0};
        for (int e = 0; e < NE_; ++e) {
            float a = 0.f;
#pragma unroll
            for (int j = 0; j < 4; ++j) { const f32x4 w = *(const f32x4*)(wrt + e * 1024 + 4 * lane + 256 * j); a += v[j].x * w.x + v[j].y * w.y + v[j].z * w.z + v[j].w * w.w; }
            a = wave_sum(a) + p.b_router[e];
            if (a > bv[0]) { bv[3] = bv[2]; bi[3] = bi[2]; bv[2] = bv[1]; bi[2] = bi[1]; bv[1] = bv[0]; bi[1] = bi[0]; bv[0] = a; bi[0] = e; }
            else if (a > bv[1]) { bv[3] = bv[2]; bi[3] = bi[2]; bv[2] = bv[1]; bi[2] = bi[1]; bv[1] = a; bi[1] = e; }
            else if (a > bv[2]) { bv[3] = bv[2]; bi[3] = bi[2]; bv[2] = a; bi[2] = e; }
            else if (a > bv[3]) { bv[3] = a; bi[3] = e; }
        }
        if (lane == 0) {
            const float e0 = 1.f, e1 = expf(bv[1] - bv[0]), e2 = expf(bv[2] - bv[0]), e3 = expf(bv[3] - bv[0]);
            const float inv = 1.f / (e0 + e1 + e2 + e3);
            const float gs[4] = {e0 * inv, e1 * inv, e2 * inv, e3 * inv};
#pragma unroll
            for (int k = 0; k < 4; ++k) {
                const unsigned pos = atomicAdd(&ecnt[bi[k]], 1u);
                elist[bi[k] * 32768 + pos] = t * 4 + k;
                gate[t * 4 + k] = gs[k];
            }
        }
    }
}

__device__ __forceinline__ void phase7(const Params& p, int bid, int nb, LAS unsigned char* lds) {
    const int lane = tidx() & 63, wave = tidx() >> 6, lr = lane & 15, g = lane >> 4;
    const bf16_t* H2 = (const bf16_t*)(p.ws + OFF_H);
    const bf16_t* WGU = (const bf16_t*)(p.ws + OFF_WGU);
    bf16_t* ACT = (bf16_t*)(p.ws + OFF_ACT);
    const unsigned* ecnt = (const unsigned*)(p.ws + OFF_CTL) + CW_ECNT;
    const int* elist = (const int*)(p.ws + OFF_ELIST);
    LAS int* pre = (LAS int*)lds;
    if (tidx() == 0) { int a = 0; for (int e = 0; e < NE_; ++e) { pre[e] = a; a += ((int)ecnt[e] + 127) / 128; } pre[NE_] = a; }
    __syncthreads();
    const int total = pre[NE_] * 32;
    for (int u = bid; u < total; u += nb) {
        const int mtg = u / 32, nt = u % 32;
        int e = 0; while (pre[e + 1] <= mtg) ++e;
        const int mt = mtg - pre[e], cnt = (int)ecnt[e];
        const int r = mt * 128 + wave * 16 + lr;
        const int ent = elist[e * 32768 + (r < cnt ? r : 0)];
        const bf16_t* arow = H2 + (size_t)(ent >> 2) * D_;
        const bf16_t* wb = WGU + (size_t)e * 2048 * 1024;
        const bf16_t* bcol[4];
        bcol[0] = wb + (size_t)(nt * 32 + lr) * D_; bcol[1] = wb + (size_t)(nt * 32 + 16 + lr) * D_;
        bcol[2] = wb + (size_t)(1024 + nt * 32 + lr) * D_; bcol[3] = wb + (size_t)(1024 + nt * 32 + 16 + lr) * D_;
        f32x4 acc[4];
        wave_gemm<4>(arow, bcol, D_, acc);
#pragma unroll
        for (int n = 0; n < 2; ++n) {
            const int c = nt * 32 + 16 * n + lr;
            const float bg = p.b_gu[e * 2048 + c], bu = p.b_gu[e * 2048 + 1024 + c];
#pragma unroll
            for (int j = 0; j < 4; ++j) {
                const int rr = mt * 128 + wave * 16 + 4 * g + j;
                if (rr < cnt) {
                    const int en = elist[e * 32768 + rr];
                    const float gv = fminf(acc[n][j] + bg, 7.f);
                    const float uv = fminf(fmaxf(acc[n + 2][j] + bu, -7.f), 7.f);
                    const float a = (uv + 1.f) * gv * sigmoidf_(1.702f * gv);
                    ACT[(size_t)en * DFF_ + c] = f2bf(a);
                }
            }
        }
    }
}

__device__ __forceinline__ void phase8(const Params& p, int bid, int nb, LAS unsigned char* lds) {
    const int lane = tidx() & 63, wave = tidx() >> 6, lr = lane & 15, g = lane >> 4;
    const bf16_t* ACT = (const bf16_t*)(p.ws + OFF_ACT);
    const bf16_t* WDN = (const bf16_t*)(p.ws + OFF_WDN);
    bf16_t* OUT2 = (bf16_t*)(p.ws + OFF_OUT2);
    const unsigned* ecnt = (const unsigned*)(p.ws + OFF_CTL) + CW_ECNT;
    const int* elist = (const int*)(p.ws + OFF_ELIST);
    const float* gate = (const float*)(p.ws + OFF_GATE);
    LAS int* pre = (LAS int*)lds;
    __syncthreads();
    if (tidx() == 0) { int a = 0; for (int e = 0; e < NE_; ++e) { pre[e] = a; a += ((int)ecnt[e] + 127) / 128; } pre[NE_] = a; }
    __syncthreads();
    const int total = pre[NE_] * 16;
    for (int u = bid; u < total; u += nb) {
        const int mtg = u / 16, nt = u % 16;
        int e = 0; while (pre[e + 1] <= mtg) ++e;
        const int mt = mtg - pre[e], cnt = (int)ecnt[e];
        const int r = mt * 128 + wave * 16 + lr;
        const int ent = elist[e * 32768 + (r < cnt ? r : 0)];
        const bf16_t* arow = ACT + (size_t)ent * DFF_;
        const bf16_t* wb = WDN + (size_t)e * 1024 * 1024;
        const bf16_t* bcol[4];
#pragma unroll
        for (int n = 0; n < 4; ++n) bcol[n] = wb + (size_t)(nt * 64 + 16 * n + lr) * DFF_;
        f32x4 acc[4];
        wave_gemm<4>(arow, bcol, DFF_, acc);
#pragma unroll
        for (int n = 0; n < 4; ++n) {
            const int c = nt * 64 + 16 * n + lr;
            const float bd = p.b_dn[e * 1024 + c];
#pragma unroll
            for (int j = 0; j < 4; ++j) {
                const int rr = mt * 128 + wave * 16 + 4 * g + j;
                if (rr < cnt) {
                    const int en = elist[e * 32768 + rr];
                    OUT2[(size_t)en * D_ + c] = f2bf((acc[n][j] + bd) * gate[en]);
                }
            }
        }
    }
}


#define XB_TMO      128
#define XB_XCNT(j)  (256  + 64 * (j))
#define XB_XSUB(j)  (1280 + 64 * (j))
#define XB_XGEN(j)  (2304 + 64 * (j))
#define XB_TOP      3328
#define XB_TOPGEN   3392
#define XCD_BAR_WORDS 3456
#define XB_SPIN_CAP (1u << 18)
__device__ __forceinline__ unsigned xb_ld(unsigned* p)              { return __hip_atomic_load(p, __ATOMIC_RELAXED, __HIP_MEMORY_SCOPE_AGENT); }
__device__ __forceinline__ unsigned xb_add(unsigned* p, unsigned v) { return __hip_atomic_fetch_add(p, v, __ATOMIC_RELAXED, __HIP_MEMORY_SCOPE_AGENT); }
__device__ __forceinline__ unsigned xb_xcc_id() { return (unsigned)__builtin_amdgcn_s_getreg((3 << 11) | 20) & 0xFu; }
#define XB_SPIN(cond, bar) do { unsigned _sp = 0; while (cond) { __builtin_amdgcn_s_sleep(1); \
    if ((++_sp & 255u) == 0u) { if (xb_ld(&(bar)[XB_TMO])) break; if (_sp > XB_SPIN_CAP) { atomicAdd(&(bar)[XB_TMO], 1u); break; } } } } while (0)
struct XcdBarrier { unsigned* bar; unsigned x; volatile LAS unsigned* st; };
__device__ __forceinline__ XcdBarrier xcd_barrier_post(unsigned* bar, volatile LAS unsigned* st) {
    XcdBarrier b; b.bar = bar; b.x = xb_xcc_id(); b.st = st;
    if (tidx() == 0) (void)xb_add(&bar[XB_XCNT(b.x)], 1u);
    return b;
}
__device__ __forceinline__ void xcd_barrier_complete(unsigned* bar, unsigned x, unsigned& nloc, unsigned& nx) {
    const unsigned G = gridDim.x * gridDim.y * gridDim.z;
    unsigned sum, cnt, mine, sp = 0u;
    for (;;) {
        sum = 0u; cnt = 0u; mine = 0u;
#pragma unroll
        for (unsigned j = 0; j < 16; ++j) { const unsigned c = xb_ld(&bar[XB_XCNT(j)]); sum += c; cnt += (c > 0u) ? 1u : 0u; mine = (j == x) ? c : mine; }
        if (sum == G) break;
        __builtin_amdgcn_s_sleep(1);
        if ((++sp & 255u) == 0u) { if (xb_ld(&bar[XB_TMO])) break; if (sp > XB_SPIN_CAP) { atomicAdd(&bar[XB_TMO], 1u); break; } }
    }
    nloc = mine > 0u ? mine : 1u; nx = cnt > 0u ? cnt : 1u;
}
__device__ __forceinline__ void xcd_barrier(const XcdBarrier& b) {
    asm volatile("s_waitcnt vmcnt(0)" ::: "memory");
    __syncthreads();
    if (tidx() == 0) {
        unsigned* bar = b.bar;
        __builtin_amdgcn_s_waitcnt(0);
        unsigned nloc = b.st[0], nx = b.st[1];
        if (nloc == 0u) { xcd_barrier_complete(bar, b.x, nloc, nx); b.st[0] = nloc; b.st[1] = nx; }
        const unsigned old = xb_add(&bar[XB_XSUB(b.x)], 1u);
        const unsigned gen = old / nloc;
        if (old + 1u == (gen + 1u) * nloc) {
            __builtin_amdgcn_fence(__ATOMIC_RELEASE, "agent");
            asm volatile("s_waitcnt vmcnt(0)" ::: "memory");
            const unsigned og = xb_add(&bar[XB_TOP], 1u);
            const unsigned tg = og / nx;
            if (og + 1u == (tg + 1u) * nx) xb_add(&bar[XB_TOPGEN], 1u);
            else XB_SPIN(xb_ld(&bar[XB_TOPGEN]) == tg, bar);
            __builtin_amdgcn_fence(__ATOMIC_ACQUIRE, "agent");
            xb_add(&bar[XB_XGEN(b.x)], 1u);
            asm volatile("s_waitcnt vmcnt(0)" ::: "memory");
        } else {
            XB_SPIN(xb_ld(&bar[XB_XGEN(b.x)]) == gen, bar);
            __builtin_amdgcn_fence(__ATOMIC_ACQUIRE, "agent");
            asm volatile("s_waitcnt vmcnt(0)" ::: "memory");
        }
    }
    __syncthreads();
}

constexpr size_t OFF_MODP = OFF_X + 24 * MBy;
__device__ __forceinline__ void p0_transpose_item(const float* W, int K, int N, bf16_t* WT, LAS float* scr, int item, int lane) {
    const int nblk = N / 32, kb = item / nblk, nbk = item % nblk, k0 = 64 * kb, n0 = 32 * nbk;
#pragma unroll 8
    for (int i = 0; i < 32; ++i) { const int kk = 2 * i + (lane >> 5); scr[kk * 33 + (lane & 31)] = __builtin_nontemporal_load(W + (size_t)(k0 + kk) * N + n0 + (lane & 31)); }
    asm volatile("s_waitcnt lgkmcnt(0)" ::: "memory");
    const int c = lane & 7;
#pragma unroll
    for (int j = 0; j < 4; ++j) { const int n = (lane >> 3) + 8 * j; const LAS float* s = scr + (8 * c) * 33 + n;
        u32x4 o; o.x = pk2(s[0 * 33], s[1 * 33]); o.y = pk2(s[2 * 33], s[3 * 33]); o.z = pk2(s[4 * 33], s[5 * 33]); o.w = pk2(s[6 * 33], s[7 * 33]);
        *(u32x4*)(WT + (size_t)(n0 + n) * K + k0 + 8 * c) = o; }
    asm volatile("s_waitcnt lgkmcnt(0)" ::: "memory");
}
__device__ __forceinline__ void p0_transpose_item8(const float* W, int K, int N, unsigned char* WT, LAS float* scr, int item, int lane) {
    const int nblk = N / 32, kb = item / nblk, nbk = item % nblk, k0 = 64 * kb, n0 = 32 * nbk;
#pragma unroll 8
    for (int i = 0; i < 32; ++i) { const int kk = 2 * i + (lane >> 5); scr[kk * 33 + (lane & 31)] = __builtin_nontemporal_load(W + (size_t)(k0 + kk) * N + n0 + (lane & 31)) * W8_SCALE; }
    asm volatile("s_waitcnt lgkmcnt(0)" ::: "memory");
    const int c = lane & 7;
#pragma unroll
    for (int j = 0; j < 4; ++j) { const int n = (lane >> 3) + 8 * j; const LAS float* s = scr + (8 * c) * 33 + n;
        uint2 o; o.x = pk4_fp8(s[0 * 33], s[1 * 33], s[2 * 33], s[3 * 33]); o.y = pk4_fp8(s[4 * 33], s[5 * 33], s[6 * 33], s[7 * 33]);
        *(uint2*)(WT + (size_t)(n0 + n) * K + k0 + 8 * c) = o; }
    asm volatile("s_waitcnt lgkmcnt(0)" ::: "memory");
}
__device__ __forceinline__ void phase0_fast(const Params& p, int bid, int nb, LAS unsigned char* lds) {
    const int tid = tidx(), lane = tid & 63, wave = tid >> 6;
    {
        LAS float* sl = (LAS float*)lds;
        LAS float* red = sl + 256;
        float* modp = (float*)(p.ws + OFF_MODP);
        for (int item = bid; item < 24 * 8; item += nb) {
            const int ct = item % 24, ks = item / 24;
            __syncthreads();
            if (tid < 256) { const int bb = tid >> 7, kk = tid & 127; sl[tid] = siluf_(p.c[bb * D_ + ks * 128 + kk]); }
            __syncthreads();
            const int col = ct * 256 + (tid & 255), kh = tid >> 8;
            const float* wp = p.w_ada + (size_t)(ks * 128 + kh * 64) * NMOD + col;
            float a0 = 0.f, a1 = 0.f;
#pragma unroll 16
            for (int k = 0; k < 64; ++k) { const float wv = wp[(size_t)k * NMOD]; a0 += sl[kh * 64 + k] * wv; a1 += sl[128 + kh * 64 + k] * wv; }
            if (kh == 1) { red[tid & 255] = a0; red[256 + (tid & 255)] = a1; }
            __syncthreads();
            if (kh == 0) { modp[(ks * 2 + 0) * NMOD + col] = a0 + red[tid]; modp[(ks * 2 + 1) * NMOD + col] = a1 + red[256 + tid]; }
        }
        __syncthreads();
    }
    float* cs = (float*)(p.ws + OFF_CS);
    for (int i = bid * NTHREADS + tid; i < T_ * 8; i += nb * NTHREADS) {
        const int t = i >> 3, f = i & 7;
        float a = (float)(-13.122363377404328) * (float)(2 * f); a = a / 16.0f;
        const float invf = expf(a);
        const float ang = (float)p.pos[t] * invf;
        cs[t * 16 + f] = cosf(ang); cs[t * 16 + 8 + f] = sinf(ang);
    }
    { float* lbt = (float*)(p.ws + OFF_LB); for (int j = bid * NTHREADS + tid; j < HW_; j += nb * NTHREADS) lbt[j] = 1.f / (1.f + expf(p.lb_logits[HW_ + j] - p.lb_logits[j])); }
    LAS float* scr = (LAS float*)(lds + wave * 8448);
    const int gw = bid * NWAVES + wave, NGW = nb * NWAVES;
    constexpr int I_IN = 16 * (NPROJ / 32), I_OUT = 16 * 32, I_GU = 16 * 64, I_DN = 16 * 32;
    constexpr int NITEMS = I_IN + I_OUT + NE_ * I_GU + NE_ * I_DN;
    for (int it = gw; it < NITEMS; it += NGW) {
        int r = it;
        if (r < I_IN) { if (INPROJ_FP8 && (r % (NPROJ / 32)) < 3072 / 32) p0_transpose_item8(p.w_in, D_, NPROJ, (unsigned char*)(p.ws + OFF_WIN8), scr, r, lane); else p0_transpose_item(p.w_in, D_, NPROJ, (bf16_t*)(p.ws + OFF_WIN), scr, r, lane); continue; } r -= I_IN;
        if (r < I_OUT) { p0_transpose_item(p.w_out, D_, D_, (bf16_t*)(p.ws + OFF_WOUT), scr, r, lane); continue; } r -= I_OUT;
        if (r < NE_ * I_GU) { const int e = r / I_GU;
            if (MOE_FP8) p0_transpose_item8(p.w_gu + (size_t)e * 1024 * 2048, D_, 2048, (unsigned char*)(p.ws + OFF_WGU) + (size_t)e * 2048 * 1024, scr, r % I_GU, lane);
            else p0_transpose_item(p.w_gu + (size_t)e * 1024 * 2048, D_, 2048, (bf16_t*)(p.ws + OFF_WGU) + (size_t)e * 2048 * 1024, scr, r % I_GU, lane); continue; } r -= NE_ * I_GU;
        { const int e = r / I_DN;
            if (MOE_FP8) p0_transpose_item8(p.w_dn + (size_t)e * 1024 * 1024, DFF_, D_, (unsigned char*)(p.ws + OFF_WDN) + (size_t)e * 1024 * 1024, scr, r % I_DN, lane);
            else p0_transpose_item(p.w_dn + (size_t)e * 1024 * 1024, DFF_, D_, (bf16_t*)(p.ws + OFF_WDN) + (size_t)e * 1024 * 1024, scr, r % I_DN, lane); }
    }
}

__device__ __forceinline__ void phase1_fast(const Params& p, int bid, int nb, LAS unsigned char* lds) {
    const int tid = tidx(), lane = tid & 63, wave = tid >> 6;
    const float* modp = (const float*)(p.ws + OFF_MODP);
    float* mod = (float*)(p.ws + OFF_MOD);
    for (int i = bid * NTHREADS + tid; i < 2 * NMOD; i += nb * NTHREADS) {
        const int bb = i / NMOD, j = i % NMOD; float a = p.b_ada[j];
#pragma unroll
        for (int ks = 0; ks < 8; ++ks) a += modp[(ks * 2 + bb) * NMOD + j];
        mod[i] = a;
    }
    LAS float* msh = (LAS float*)lds;
    LAS float* msc = msh + 1024;
    bf16_t* H = (bf16_t*)(p.ws + OFF_H);
    for (int item = bid; item < T_ / 128; item += nb) {
        const int b = (item * 128) / S_;
        __syncthreads();
        for (int i = tid; i < 2048; i += NTHREADS) {
            const int j = i;
            float a = p.b_ada[j];
#pragma unroll
            for (int ks = 0; ks < 8; ++ks) a += modp[(ks * 2 + b) * NMOD + j];
            if (i < 1024) msh[i] = a; else msc[i - 1024] = (1.f + a) * p.norm1_g[i - 1024];
        }
        __syncthreads();
        for (int r = wave; r < 128; r += NWAVES) {
            const int t = item * 128 + r;
            const f32x4* xr = (const f32x4*)(p.x + (size_t)t * D_) + lane;
            f32x4 v[4]; float s = 0.f;
#pragma unroll
            for (int j = 0; j < 4; ++j) { v[j] = xr[64 * j]; s += v[j].x * v[j].x + v[j].y * v[j].y + v[j].z * v[j].z + v[j].w * v[j].w; }
            const float rstd = rsqrtf(wave_sum(s) * (1.f / D_) + RMS_EPS);
#pragma unroll
            for (int j = 0; j < 4; ++j) {
                const int k = 4 * lane + 256 * j;
                const f32x4 sc = *(const LAS f32x4*)(msc + k), sh = *(const LAS f32x4*)(msh + k);
                const float h0 = v[j].x * rstd * sc.x + sh.x, h1 = v[j].y * rstd * sc.y + sh.y, h2v = v[j].z * rstd * sc.z + sh.z, h3 = v[j].w * rstd * sc.w + sh.w;
                uint2 w; w.x = pk2(h0, h1); w.y = pk2(h2v, h3);
                *(uint2*)(H + (size_t)t * D_ + k) = w;
                if (INPROJ_FP8) *(unsigned*)((unsigned char*)(p.ws + OFF_H8) + (size_t)t * D_ + k) = pk4_fp8(fminf(fmaxf(h0, -448.f), 448.f), fminf(fmaxf(h1, -448.f), 448.f), fminf(fmaxf(h2v, -448.f), 448.f), fminf(fmaxf(h3, -448.f), 448.f));
            }
        }
    }
}

__device__ __forceinline__ void phase6_fast(const Params& p, int bid, int nb, LAS unsigned char* lds, bool dummy = false) {
    const int tid = tidx(), lane = tid & 63, w = tid >> 6, fr = lane & 15, g = lane >> 4;
    const float* mod = (const float*)(p.ws + OFF_MOD);
    LAS bf16_t* WH = (LAS bf16_t*)lds;
    LAS bf16_t* WL = WH + 32 * 1032;
    LAS float* LG = (LAS float*)(WL + 32 * 1032);
    LAS float* biasl = LG + 128 * 33;
    LAS float* rstdl = biasl + 32;
    LAS int* cntl = (LAS int*)(rstdl + 128);
    LAS int* basel = cntl + 32;
    LAS float* red = (LAS float*)(basel + 32);
    bf16_t* H2 = (bf16_t*)(p.ws + OFF_H);
    const bf16_t* X1B = (const bf16_t*)(p.ws + OFF_X1B);
    unsigned* ecnt = (unsigned*)(p.ws + OFF_CTL) + (dummy ? 640 : CW_ECNT);
    int* elist = (int*)(p.ws + (dummy ? OFF_U : OFF_ELIST));
    float* gate = (float*)(p.ws + (dummy ? OFF_U + 8 * MBy : OFF_GATE));
    int cur_b = -1;
    for (int item = bid; item < T_ / 128; item += nb) {
        const int b = (item * 128) / S_;
        const float* sh2 = mod + b * NMOD + 3 * D_, *sc2 = mod + b * NMOD + 4 * D_;
        __syncthreads();
        if (b != cur_b) {
            cur_b = b;
            float bp = 0.f;
            for (int idx = tid; idx < 32768; idx += NTHREADS) {
                const int k = idx >> 5, e = idx & 31;
                const float wv = p.w_router[idx];
                const float val = wv * p.norm2_g[k] * (1.f + sc2[k]);
                const bf16_t hi = f2bf(val); const bf16_t lo = f2bf(val - bf2f(hi));
                WH[e * 1032 + k] = hi; WL[e * 1032 + k] = lo;
                bp += sh2[k] * wv;
            }
            red[(tid >> 5) * 32 + (tid & 31)] = bp;
            __syncthreads();
            if (tid < 32) { float a = p.b_router[tid];
#pragma unroll
                for (int i = 0; i < 16; ++i) a += red[i * 32 + tid];
                biasl[tid] = a; }
        }
        if (tid < 32) cntl[tid] = 0;
        __syncthreads();
        {
            const int t = item * 128 + 16 * w + fr;
            const bf16_t* xr = X1B + (size_t)t * D_ + 8 * g;
            f32x4 acc0 = (f32x4){0.f, 0.f, 0.f, 0.f}, acc1 = (f32x4){0.f, 0.f, 0.f, 0.f};
            float ssq = 0.f;
            const LAS bf16_t* wh0 = WH + fr * 1032 + 8 * g; const LAS bf16_t* wl0 = WL + fr * 1032 + 8 * g;
#pragma unroll 4
            for (int ks = 0; ks < 32; ++ks) {
                const u32x4 xw = *(const u32x4*)(xr + 32 * ks);
                const bf16x8 a = __builtin_bit_cast(bf16x8, xw);
#pragma unroll
                for (int c = 0; c < 4; ++c) { const float lo = __uint_as_float(xw[c] << 16), hi = __uint_as_float(xw[c] & 0xffff0000u); ssq += lo * lo + hi * hi; }
                const bf16x8 bh0 = *(const LAS bf16x8*)(wh0 + 32 * ks), bl0 = *(const LAS bf16x8*)(wl0 + 32 * ks);
                const bf16x8 bh1 = *(const LAS bf16x8*)(wh0 + 16 * 1032 + 32 * ks), bl1 = *(const LAS bf16x8*)(wl0 + 16 * 1032 + 32 * ks);
                acc0 = __builtin_amdgcn_mfma_f32_16x16x32_bf16(a, bh0, acc0, 0, 0, 0); acc1 = __builtin_amdgcn_mfma_f32_16x16x32_bf16(a, bh1, acc1, 0, 0, 0);
                acc0 = __builtin_amdgcn_mfma_f32_16x16x32_bf16(a, bl0, acc0, 0, 0, 0); acc1 = __builtin_amdgcn_mfma_f32_16x16x32_bf16(a, bl1, acc1, 0, 0, 0);
            }
            ssq += __shfl_xor(ssq, 16); ssq += __shfl_xor(ssq, 32);
            if (g == 0) rstdl[16 * w + fr] = rsqrtf(ssq * (1.f / D_) + RMS_EPS);
            __syncthreads();
#pragma unroll
            for (int j = 0; j < 4; ++j) {
                const int tl = 16 * w + 4 * g + j; const float rs = rstdl[tl];
                LG[tl * 33 + fr] = acc0[j] * rs + biasl[fr];
                LG[tl * 33 + 16 + fr] = acc1[j] * rs + biasl[16 + fr];
            }
        }
        __syncthreads();
        int bi[4] = {0, 0, 0, 0}; float gs[4] = {0.f, 0.f, 0.f, 0.f}; int rk[4] = {0, 0, 0, 0};
        if (tid < 128) {
            float bv[4] = {-INFINITY, -INFINITY, -INFINITY, -INFINITY};
            for (int e = 0; e < NE_; ++e) {
                const float a = LG[tid * 33 + e];
                if (a > bv[0]) { bv[3] = bv[2]; bi[3] = bi[2]; bv[2] = bv[1]; bi[2] = bi[1]; bv[1] = bv[0]; bi[1] = bi[0]; bv[0] = a; bi[0] = e; }
                else if (a > bv[1]) { bv[3] = bv[2]; bi[3] = bi[2]; bv[2] = bv[1]; bi[2] = bi[1]; bv[1] = a; bi[1] = e; }
                else if (a > bv[2]) { bv[3] = bv[2]; bi[3] = bi[2]; bv[2] = a; bi[2] = e; }
                else if (a > bv[3]) { bv[3] = a; bi[3] = e; }
            }
            const float e1 = expf(bv[1] - bv[0]), e2 = expf(bv[2] - bv[0]), e3 = expf(bv[3] - bv[0]);
            const float inv = 1.f / (1.f + e1 + e2 + e3);
            gs[0] = inv; gs[1] = e1 * inv; gs[2] = e2 * inv; gs[3] = e3 * inv;
#pragma unroll
            for (int k = 0; k < 4; ++k) rk[k] = atomicAdd((int*)&cntl[bi[k]], 1);
        }
        __syncthreads();
        if (tid < 32) { const int cc = cntl[tid]; basel[tid] = cc ? (int)atomicAdd(&ecnt[tid], (unsigned)cc) : 0; }
        __syncthreads();
        if (tid < 128) {
            const int t = item * 128 + tid;
#pragma unroll
            for (int k = 0; k < 4; ++k) { elist[bi[k] * 32768 + basel[bi[k]] + rk[k]] = t * 4 + k; gate[t * 4 + k] = gs[k]; }
        }
        {
            f32x4 gsc[4], gsh[4];
#pragma unroll
            for (int j = 0; j < 4; ++j) { const int k = 4 * lane + 256 * j; const f32x4 gg = *(const f32x4*)(p.norm2_g + k), sc = *(const f32x4*)(sc2 + k); gsh[j] = *(const f32x4*)(sh2 + k);
                gsc[j] = (f32x4){gg[0] * (1.f + sc[0]), gg[1] * (1.f + sc[1]), gg[2] * (1.f + sc[2]), gg[3] * (1.f + sc[3])}; }
            for (int r = 0; r < 16; ++r) {
                const int t = item * 128 + 16 * w + r; const float rs = rstdl[16 * w + r];
                const uint2* xr = (const uint2*)(X1B + (size_t)t * D_) + lane;
#pragma unroll
                for (int j = 0; j < 4; ++j) { const uint2 xw = xr[64 * j];
                    const f32x4 v = (f32x4){__uint_as_float(xw.x << 16), __uint_as_float(xw.x & 0xffff0000u), __uint_as_float(xw.y << 16), __uint_as_float(xw.y & 0xffff0000u)};
                    const float h0 = v[0] * rs * gsc[j][0] + gsh[j][0], h1 = v[1] * rs * gsc[j][1] + gsh[j][1], h2v = v[2] * rs * gsc[j][2] + gsh[j][2], h3 = v[3] * rs * gsc[j][3] + gsh[j][3];
                    if (MOE_FP8) { *(unsigned*)((unsigned char*)H2 + (size_t)t * D_ + 4 * lane + 256 * j) = pk4_fp8(fminf(fmaxf(h0, -448.f), 448.f), fminf(fmaxf(h1, -448.f), 448.f), fminf(fmaxf(h2v, -448.f), 448.f), fminf(fmaxf(h3, -448.f), 448.f)); }
                    else { uint2 o; o.x = pk2(h0, h1); o.y = pk2(h2v, h3); *(uint2*)(H2 + (size_t)t * D_ + 4 * lane + 256 * j) = o; } }
            }
        }
    }
    __syncthreads();
}

__device__ __forceinline__ void phase9(const Params& p, int bid, int nb) {
    const int lane = tidx() & 63, wave = tidx() >> 6;
    const float* mod = (const float*)(p.ws + OFF_MOD);
    const bf16_t* OUT2 = (const bf16_t*)(p.ws + OFF_OUT2);
    for (int t = bid * NWAVES + wave; t < T_; t += nb * NWAVES) {
        const int b = t / S_;
        f32x4* xr = (f32x4*)(p.out + (size_t)t * D_) + lane;
        const float* g2 = mod + b * NMOD + 5 * D_;
        f32x4 v[4]; float s = 0.f;
#pragma unroll
        for (int j = 0; j < 4; ++j) {
            const int k = 4 * lane + 256 * j;
            v[j] = xr[64 * j];
            f32x4 y = (f32x4){0.f, 0.f, 0.f, 0.f};
#pragma unroll
            for (int kk = 0; kk < 4; ++kk) { const uint2 w = *(const uint2*)(OUT2 + (size_t)(t * 4 + kk) * D_ + k);
                y.x += __uint_as_float(w.x << 16); y.y += __uint_as_float(w.x & 0xffff0000u); y.z += __uint_as_float(w.y << 16); y.w += __uint_as_float(w.y & 0xffff0000u); }
            const f32x4 gg = *(const f32x4*)(g2 + k);
            v[j].x += gg.x * y.x; v[j].y += gg.y * y.y; v[j].z += gg.z * y.z; v[j].w += gg.w * y.w;
            s += v[j].x * v[j].x + v[j].y * v[j].y + v[j].z * v[j].z + v[j].w * v[j].w;
        }
        const float rstd = rsqrtf(wave_sum(s) * (1.f / D_) + RMS_EPS);
#pragma unroll
        for (int j = 0; j < 4; ++j) {
            const f32x4 fg = *(const f32x4*)(p.final_g + 4 * lane + 256 * j);
            f32x4 o; o.x = v[j].x * rstd * fg.x; o.y = v[j].y * rstd * fg.y; o.z = v[j].z * rstd * fg.z; o.w = v[j].w * rstd * fg.w;
            xr[64 * j] = o;
        }
    }
}


__device__ __forceinline__ void phase9_fast(const Params& p, int bid, int nb) {
    const int lane = tidx() & 63, wave = tidx() >> 6;
    const float* mod = (const float*)(p.ws + OFF_MOD);
    const unsigned char* OUT2 = (const unsigned char*)(p.ws + OFF_OUT2);
    const bf16_t* X1B = (const bf16_t*)(p.ws + OFF_X1B);
    typedef float f32x2 __attribute__((ext_vector_type(2)));
    for (int t = bid * NWAVES + wave; t < T_; t += nb * NWAVES) {
        const int b = t / S_;
        const float* g2 = mod + b * NMOD + 5 * D_;
        f32x4 v[4]; float s = 0.f;
#pragma unroll
        for (int j = 0; j < 4; ++j) {
            const int k = 4 * lane + 256 * j;
            const uint2 xw = *(const uint2*)(X1B + (size_t)t * D_ + k);
            f32x4 y = (f32x4){0.f, 0.f, 0.f, 0.f};
#pragma unroll
            for (int kk = 0; kk < 4; ++kk) { const int wv = *(const int*)(OUT2 + (size_t)(t * 4 + kk) * D_ + k);
                const f32x2 lo = __builtin_amdgcn_cvt_pk_f32_fp8(wv, false), hi = __builtin_amdgcn_cvt_pk_f32_fp8(wv, true);
                y[0] += lo[0]; y[1] += lo[1]; y[2] += hi[0]; y[3] += hi[1]; }
            const f32x4 gg = *(const f32x4*)(g2 + k);
            v[j][0] = __uint_as_float(xw.x << 16) + gg[0] * y[0] * OUT2_INV; v[j][1] = __uint_as_float(xw.x & 0xffff0000u) + gg[1] * y[1] * OUT2_INV;
            v[j][2] = __uint_as_float(xw.y << 16) + gg[2] * y[2] * OUT2_INV; v[j][3] = __uint_as_float(xw.y & 0xffff0000u) + gg[3] * y[3] * OUT2_INV;
            s += v[j][0] * v[j][0] + v[j][1] * v[j][1] + v[j][2] * v[j][2] + v[j][3] * v[j][3];
        }
        const float rstd = rsqrtf(wave_sum(s) * (1.f / D_) + RMS_EPS);
        f32x4* orow = (f32x4*)(p.out + (size_t)t * D_) + lane;
#pragma unroll
        for (int j = 0; j < 4; ++j) {
            const f32x4 fg = *(const f32x4*)(p.final_g + 4 * lane + 256 * j);
            orow[64 * j] = (f32x4){v[j][0] * rstd * fg[0], v[j][1] * rstd * fg[1], v[j][2] * rstd * fg[2], v[j][3] * rstd * fg[3]};
        }
    }
}
constexpr int LDS_BYTES = 155648;

template <int PH>
__device__ __forceinline__ void run_phase(const Params& p, int bid, int nb, LAS unsigned char* lds) {
    if (PH == 0) { if (FAST0) phase0_fast(p, bid, nb, lds); else phase0(p, bid, nb, lds); }
    if (PH == 1) { if (FAST0) phase1_fast(p, bid, nb, lds); else phase1(p, bid, nb); }
    if (PH == 2) { if (FAST2) phase2_fast(p, bid, nb, lds); else phase2(p, bid, nb); }
    if (PH == 3) { phase3(p, bid, nb); if (HG_FAST) { HgRegs<2> rg; if (bid < NB_ * NHH * 256) hgrn_local_load(p, bid, rg); for (int u = bid; u < NB_ * NHH * 256; u += nb) hgrn_local_unit2(p, u, (u + nb < NB_ * NHH * 256) ? u + nb : -1, rg, lds); __syncthreads(); } if (MB_FAST) moba_kmean(p, bid, nb, lds); }
    if (PH == 10) { if (P3B_WS) phase3b_ws(p, bid, nb, lds); else { if (HG_FAST) hgrn_scan(p, bid, nb); if (MB_FAST) moba_gating(p, bid, nb, lds); } }
    if (PH == 4) { phase4(p, bid, nb); for (int rep = 0; rep < 1 + (PROBE4 & 1); ++rep) { HgOutRegs rg; if (bid < NB_ * NHH * 256) hgrn_out_load(p, bid, rg); for (int u = bid; u < NB_ * NHH * 256; u += nb) hgrn_out_unit2(p, u, (u + nb < NB_ * NHH * 256) ? u + nb : -1, rg, lds); __syncthreads(); } for (int rep = 0; rep < 1 + ((PROBE4 >> 1) & 1); ++rep) moba_tiles(p, bid, nb, lds); }
    if (PH == 11) { if (MB_FAST) moba_combine(p, bid, nb); }
    if (PH == 5) { if (FAST5) phase5_fast(p, bid, nb, lds); else phase5(p, bid, nb); }
    if (PH == 6) { if (PROBEX & 4) phase6_fast(p, bid, nb, lds, true); if (FAST6) phase6_fast(p, bid, nb, lds); else phase6(p, bid, nb); }
    if (PH == 7) { if (MOE_FP8) phase_moe_fast8<1>(p, bid, nb, lds); else if (FAST7) phase_moe_fast<1>(p, bid, nb, lds); else phase7(p, bid, nb, lds); }
    if (PH == 8) { if (MOE_FP8) phase_moe_fast8<2>(p, bid, nb, lds); else if (FAST8) phase_moe_fast<2>(p, bid, nb, lds); else phase8(p, bid, nb, lds); }
    if (PH == 9) { if (PROBEX & 8) phase9_fast(p, bid, nb); phase9_fast(p, bid, nb); }
}

template <int PH>
__global__ void __launch_bounds__(NTHREADS, 2) k_phase(Params p) {
    extern __shared__ __attribute__((aligned(16))) unsigned char lds_raw[];
    run_phase<PH>(p, blockIdx.x, gridDim.x, (LAS unsigned char*)lds_raw);
}

__global__ void __launch_bounds__(NTHREADS, 2) k_mega(Params p) {
    extern __shared__ __attribute__((aligned(16))) unsigned char lds_raw[];
    LAS unsigned char* lds = (LAS unsigned char*)lds_raw;
    cg::grid_group grid = cg::this_grid();
    const int bid = blockIdx.x, nb = gridDim.x;
    volatile LAS unsigned* xbw = (volatile LAS unsigned*)(lds + LDS_BYTES - 16);
    if (tidx() == 0) { xbw[0] = 0u; xbw[1] = 0u; }
    __syncthreads();
    (void)xcd_barrier_post((unsigned*)(p.ws + OFF_CTL) + CW_BAR, xbw);
#define GSYNC() do { if (XBAR) { XcdBarrier _xb; _xb.bar = (unsigned*)(p.ws + OFF_CTL) + CW_BAR; _xb.x = xb_xcc_id(); _xb.st = (volatile LAS unsigned*)(lds + LDS_BYTES - 16); xcd_barrier(_xb); } else grid.sync(); } while (0)
#define RUNP(PH) do { run_phase<PH>(p, bid, nb, lds); GSYNC(); if ((PROBE_DUP >> PH) & 1) { run_phase<PH>(p, bid, nb, lds); GSYNC(); } } while (0)
    run_phase<0>(p, bid, nb, lds); grid.sync();
    if (PROBE_DUP & 1) { run_phase<0>(p, bid, nb, lds); GSYNC(); } RUNP(1); RUNP(2); RUNP(3); RUNP(10); RUNP(4); RUNP(11); RUNP(5); RUNP(6); RUNP(7); RUNP(8);
    run_phase<9>(p, bid, nb, lds);
}

extern "C" void kernel_launch(void* const* d_in, const int* in_sizes, int n_in, void* d_out, int out_size, void* d_ws, size_t ws_size, hipStream_t stream) {
    static int grid = 0;
    if (grid == 0) {
        if (n_in != 19 || ws_size < WS_END) { fprintf(stderr, "kernel_launch: unexpected n_in %d or ws_size %zu (< %zu)\n", n_in, ws_size, (size_t)WS_END); grid = -1; return; }
        int dev = 0, cus = 0, per_cu = 0;
        (void)hipGetDevice(&dev); (void)hipDeviceGetAttribute(&cus, hipDeviceAttributeMultiprocessorCount, dev);
        if (hipFuncSetAttribute((const void*)k_mega, hipFuncAttributeMaxDynamicSharedMemorySize, LDS_BYTES) != hipSuccess) { fprintf(stderr, "hipFuncSetAttribute failed\n"); }
        (void)hipOccupancyMaxActiveBlocksPerMultiprocessor(&per_cu, (const void*)k_mega, NTHREADS, LDS_BYTES);
        if (per_cu < 1) { fprintf(stderr, "kernel_launch: occupancy query says %d blocks per CU\n", per_cu); per_cu = 1; }
        grid = cus;
        (void)hipGetLastError();
    }
    if (grid < 0) return;
    Params p{};
    p.x = (const float*)d_in[0]; p.c = (const float*)d_in[1]; p.pos = (const int*)d_in[2];
    p.w_ada = (const float*)d_in[3]; p.b_ada = (const float*)d_in[4]; p.norm1_g = (const float*)d_in[5]; p.w_in = (const float*)d_in[6];
    p.lb_logits = (const float*)d_in[7]; p.hgrn_norm_g = (const float*)d_in[8]; p.attn_norm_g = (const float*)d_in[9]; p.w_out = (const float*)d_in[10];
    p.norm2_g = (const float*)d_in[11]; p.w_router = (const float*)d_in[12]; p.b_router = (const float*)d_in[13]; p.w_gu = (const float*)d_in[14];
    p.b_gu = (const float*)d_in[15]; p.w_dn = (const float*)d_in[16]; p.b_dn = (const float*)d_in[17]; p.final_g = (const float*)d_in[18];
    p.out = (float*)d_out; p.ws = (unsigned char*)d_ws;
    (void)hipMemsetAsync((char*)d_ws + OFF_CTL, 0, 64 * KB, stream);
#if MEGA
    void* args[] = {&p};
    hipError_t e = hipLaunchCooperativeKernel((const void*)k_mega, dim3(grid), dim3(NTHREADS), args, LDS_BYTES, stream);
    if (e != hipSuccess) fprintf(stderr, "cooperative launch failed: %s (grid %d)\n", hipGetErrorString(e), grid);
#else
    const int G = grid * 2;
    hipLaunchKernelGGL(k_phase<0>, dim3(G), dim3(NTHREADS), LDS_BYTES, stream, p);
    hipLaunchKernelGGL(k_phase<1>, dim3(G), dim3(NTHREADS), LDS_BYTES, stream, p);
    hipLaunchKernelGGL(k_phase<2>, dim3(G), dim3(NTHREADS), LDS_BYTES, stream, p);
    hipLaunchKernelGGL(k_phase<3>, dim3(G), dim3(NTHREADS), LDS_BYTES, stream, p);
    hipLaunchKernelGGL(k_phase<10>, dim3(G), dim3(NTHREADS), LDS_BYTES, stream, p);
    hipLaunchKernelGGL(k_phase<4>, dim3(G), dim3(NTHREADS), LDS_BYTES, stream, p);
    hipLaunchKernelGGL(k_phase<11>, dim3(G), dim3(NTHREADS), LDS_BYTES, stream, p);
    hipLaunchKernelGGL(k_phase<5>, dim3(G), dim3(NTHREADS), LDS_BYTES, stream, p);
    hipLaunchKernelGGL(k_phase<6>, dim3(G), dim3(NTHREADS), LDS_BYTES, stream, p);
    hipLaunchKernelGGL(k_phase<7>, dim3(G), dim3(NTHREADS), LDS_BYTES, stream, p);
    hipLaunchKernelGGL(k_phase<8>, dim3(G), dim3(NTHREADS), LDS_BYTES, stream, p);
    hipLaunchKernelGGL(k_phase<9>, dim3(G), dim3(NTHREADS), LDS_BYTES, stream, p);
#endif
}
```

```cpp
#include <hip/hip_runtime.h>
#include <hip/hip_cooperative_groups.h>
#include <cstdio>
#include <cstdint>
namespace cg = cooperative_groups;

#ifndef MEGA
#define MEGA 1
#endif
#ifndef PROBE_EPI
#define PROBE_EPI 0
#endif
#ifndef PROBEX
#define PROBEX 0
#endif
#ifndef PROBE4
#define PROBE4 0
#endif
#ifndef PROBE_DUP
#define PROBE_DUP 0
#endif
#ifndef FAST0
#define FAST0 1
#endif
#ifndef FAST6
#define FAST6 1
#endif
#ifndef XBAR
#define XBAR 1
#endif
#ifndef MOE_FP8
#define MOE_FP8 1
#endif
#ifndef INPROJ_FP8
#define INPROJ_FP8 1
#endif
#ifndef P3B_WS
#define P3B_WS 1
#endif
#ifndef HG_V2
#define HG_V2 1
#endif
#ifndef HG_FAST
#define HG_FAST 1
#endif
#ifndef MB_FAST
#define MB_FAST 1
#endif
#ifndef FAST2
#define FAST2 1
#endif
#ifndef FAST5
#define FAST5 1
#endif
#ifndef FAST7
#define FAST7 1
#endif
#ifndef FAST8
#define FAST8 1
#endif

typedef unsigned short bf16_t;
typedef short bf16x8 __attribute__((ext_vector_type(8)));
typedef float f32x4 __attribute__((ext_vector_type(4)));
typedef unsigned u32x4 __attribute__((ext_vector_type(4)));
typedef unsigned u32x2 __attribute__((ext_vector_type(2)));
#define LAS __attribute__((address_space(3)))

constexpr int NB_ = 2, S_ = 16384, T_ = NB_ * S_, D_ = 1024;
constexpr int HW_ = 768, NPROJ = 3840, NHH = 6, DK_ = 128;
constexpr int AHN = 4, HD_ = 64;
constexpr int NE_ = 32, DFF_ = 1024, TOPK_ = 4;
constexpr int NMOD = 6 * D_;
constexpr int NTHREADS = 512, NWAVES = 8;
constexpr float RMS_EPS = 1e-6f;
constexpr int C_HQ = 0, C_HF = 768, C_HI = 1536, C_HG = 2304, C_AQ = 3072, C_AK = 3328, C_AV = 3584;

constexpr size_t KB = 1024, MBy = 1024 * 1024;
constexpr size_t OFF_CTL = 0;
constexpr size_t OFF_MOD = 64 * KB;
constexpr size_t OFF_CS = 128 * KB;
constexpr size_t OFF_WRT = OFF_CS + (size_t)T_ * 16 * 4;
constexpr size_t OFF_LB = OFF_WRT + 32 * 1024 * 4;
constexpr size_t OFF_KM = OFF_LB + 4096;
constexpr size_t OFF_GATE = OFF_KM + 8 * 64 * 64 * 4;
constexpr size_t OFF_ELIST = OFF_GATE + (size_t)T_ * 4 * 4;
constexpr size_t OFF_WIN = OFF_ELIST + (size_t)32 * 32768 * 4;
constexpr size_t OFF_WOUT = OFF_WIN + (size_t)NPROJ * D_ * 2;
constexpr size_t OFF_WGU = OFF_WOUT + (size_t)D_ * D_ * 2;
constexpr size_t OFF_WDN = OFF_WGU + (size_t)NE_ * 2048 * 1024 * 2;
constexpr size_t OFF_H = OFF_WDN + (size_t)NE_ * 1024 * 1024 * 2;
constexpr size_t OFF_OP = OFF_H + (size_t)T_ * D_ * 2;
constexpr size_t OFF_MIX = OFF_OP + (size_t)T_ * D_ * 2;
constexpr size_t OFF_X = OFF_MIX + (size_t)T_ * D_ * 2;
constexpr size_t OFF_OUT2 = OFF_H;
constexpr size_t OFF_WIN8 = OFF_X + 32 * MBy;
constexpr size_t OFF_H8 = OFF_OP;
constexpr size_t OFF_X1B = OFF_X;
constexpr float OUT2_SCALE = 16.f, OUT2_INV = 1.f / 16.f;
constexpr size_t OFF_PROJ = OFF_X + (size_t)T_ * D_ * 2;
constexpr size_t OFF_U = OFF_PROJ + (size_t)T_ * NPROJ * 2;
constexpr size_t OFF_ACT = OFF_PROJ;
constexpr size_t OFF_DEC = OFF_U + (size_t)T_ * HW_ * 4;
constexpr size_t WS_END = OFF_DEC + 2 * MBy;
constexpr int CW_ECNT = 512;
constexpr int CW_BAR = 4096;

struct Params {
    const float *x, *c; const int* pos;
    const float *w_ada, *b_ada, *norm1_g, *w_in, *lb_logits, *hgrn_norm_g, *attn_norm_g, *w_out, *norm2_g, *w_router, *b_router,
        *w_gu, *b_gu, *w_dn, *b_dn, *final_g;
    float* out; unsigned char* ws;
};

__device__ __forceinline__ int tidx() { int t = threadIdx.x; asm volatile("" : "+v"(t)); return t; }
__device__ __forceinline__ float bf2f(bf16_t v) { return __uint_as_float(((unsigned)v) << 16); }
__device__ __forceinline__ bf16_t f2bf(float f) { unsigned u = __float_as_uint(f); u += 0x7FFFu + ((u >> 16) & 1u); return (bf16_t)(u >> 16); }
typedef __bf16 bf16v2_t __attribute__((ext_vector_type(2)));
__device__ __forceinline__ unsigned pk2(float lo, float hi) { bf16v2_t v = {(__bf16)lo, (__bf16)hi}; return __builtin_bit_cast(unsigned, v); }
__device__ __forceinline__ unsigned pk4_fp8(float a, float b, float c, float d) {
    int r = __builtin_amdgcn_cvt_pk_fp8_f32(a, b, 0, false);
    r = __builtin_amdgcn_cvt_pk_fp8_f32(c, d, r, true);
    return (unsigned)r;
}
constexpr float W8_SCALE = 32.f, W8_INV = 1.f / 32.f;
__device__ __forceinline__ float wave_sum(float v) {
#pragma unroll
    for (int o = 1; o < 64; o <<= 1) v += __shfl_xor(v, o);
    return v;
}
__device__ __forceinline__ float sigmoidf_(float v) { return __builtin_amdgcn_rcpf(1.f + __expf(-v)); }
__device__ __forceinline__ float siluf_(float v) { return v * __builtin_amdgcn_rcpf(1.f + __expf(-v)); }

__device__ __forceinline__ void transpose_tile(const float* W, int K, int N, bf16_t* WT, int tile, LAS float* sm) {
    const int tid = tidx();
    const int ntn = N / 64, kb = tile / ntn, nb = tile % ntn, k0 = kb * 64, n0 = nb * 64;
    {
        const int n = tid & 63, kr = tid >> 6;
#pragma unroll
        for (int i = 0; i < 8; ++i) { const int k = kr + 8 * i; sm[k * 65 + n] = W[(size_t)(k0 + k) * N + n0 + n]; }
    }
    __syncthreads();
    {
        const int n = tid >> 3, kg = tid & 7;
        u32x4 o;
        o.x = pk2(sm[(8 * kg + 0) * 65 + n], sm[(8 * kg + 1) * 65 + n]);
        o.y = pk2(sm[(8 * kg + 2) * 65 + n], sm[(8 * kg + 3) * 65 + n]);
        o.z = pk2(sm[(8 * kg + 4) * 65 + n], sm[(8 * kg + 5) * 65 + n]);
        o.w = pk2(sm[(8 * kg + 6) * 65 + n], sm[(8 * kg + 7) * 65 + n]);
        *(u32x4*)(WT + (size_t)(n0 + n) * K + k0 + 8 * kg) = o;
    }
    __syncthreads();
}

__device__ __forceinline__ void phase0(const Params& p, int bid, int nb, LAS unsigned char* lds) {
    const int tid = tidx();
    float* mod = (float*)(p.ws + OFF_MOD);
    for (int j = bid * NTHREADS + tid; j < NMOD; j += nb * NTHREADS) {
        float a0 = 0.f, a1 = 0.f;
        for (int k = 0; k < D_; ++k) {
            const float w = p.w_ada[(size_t)k * NMOD + j];
            a0 += siluf_(p.c[k]) * w; a1 += siluf_(p.c[D_ + k]) * w;
        }
        mod[j] = a0 + p.b_ada[j]; mod[NMOD + j] = a1 + p.b_ada[j];
    }
    float* cs = (float*)(p.ws + OFF_CS);
    for (int i = bid * NTHREADS + tid; i < T_ * 8; i += nb * NTHREADS) {
        const int t = i >> 3, f = i & 7;
        float a = (float)(-13.122363377404328) * (float)(2 * f); a = a / 16.0f;
        const float invf = expf(a);
        const float ang = (float)p.pos[t] * invf;
        cs[t * 16 + f] = cosf(ang); cs[t * 16 + 8 + f] = sinf(ang);
    }
    float* wrt = (float*)(p.ws + OFF_WRT);
    for (int i = bid * NTHREADS + tid; i < 32 * 1024; i += nb * NTHREADS) { const int e = i >> 10, k = i & 1023; wrt[i] = p.w_router[k * 32 + e]; }
    { float* lbt = (float*)(p.ws + OFF_LB); for (int j = bid * NTHREADS + tid; j < HW_; j += nb * NTHREADS) lbt[j] = 1.f / (1.f + expf(p.lb_logits[HW_ + j] - p.lb_logits[j])); }
    LAS float* sm = (LAS float*)lds;
    constexpr int T_IN = (D_ / 64) * (NPROJ / 64), T_OUT = 16 * 16, T_GU = 16 * 32, T_DN = 16 * 16;
    constexpr int TOTAL = T_IN + T_OUT + NE_ * T_GU + NE_ * T_DN;
    for (int it = bid; it < TOTAL; it += nb) {
        int r = it;
        if (r < T_IN) { transpose_tile(p.w_in, D_, NPROJ, (bf16_t*)(p.ws + OFF_WIN), r, sm); continue; } r -= T_IN;
        if (r < T_OUT) { transpose_tile(p.w_out, D_, D_, (bf16_t*)(p.ws + OFF_WOUT), r, sm); continue; } r -= T_OUT;
        if (r < NE_ * T_GU) { const int e = r / T_GU; transpose_tile(p.w_gu + (size_t)e * 1024 * 2048, D_, 2048, (bf16_t*)(p.ws + OFF_WGU) + (size_t)e * 2048 * 1024, r % T_GU, sm); continue; } r -= NE_ * T_GU;
        { const int e = r / T_DN; transpose_tile(p.w_dn + (size_t)e * 1024 * 1024, DFF_, D_, (bf16_t*)(p.ws + OFF_WDN) + (size_t)e * 1024 * 1024, r % T_DN, sm); }
    }
}

__device__ __forceinline__ void phase1(const Params& p, int bid, int nb) {
    const int lane = tidx() & 63, wave = tidx() >> 6;
    const float* mod = (const float*)(p.ws + OFF_MOD);
    bf16_t* H = (bf16_t*)(p.ws + OFF_H);
    for (int t = bid * NWAVES + wave; t < T_; t += nb * NWAVES) {
        const int b = t / S_;
        const f32x4* xr = (const f32x4*)(p.x + (size_t)t * D_) + lane;
        f32x4 v[4]; float s = 0.f;
#pragma unroll
        for (int j = 0; j < 4; ++j) { v[j] = xr[64 * j]; s += v[j].x * v[j].x + v[j].y * v[j].y + v[j].z * v[j].z + v[j].w * v[j].w; }
        const float rstd = rsqrtf(wave_sum(s) * (1.f / D_) + RMS_EPS);
        const float* shift = mod + b * NMOD, *scale = mod + b * NMOD + D_;
#pragma unroll
        for (int j = 0; j < 4; ++j) {
            const int k = 4 * lane + 256 * j;
            const f32x4 g = *(const f32x4*)(p.norm1_g + k), sc = *(const f32x4*)(scale + k), sh = *(const f32x4*)(shift + k);
            const float o0 = v[j].x * rstd * g.x * (1.f + sc.x) + sh.x, o1 = v[j].y * rstd * g.y * (1.f + sc.y) + sh.y;
            const float o2 = v[j].z * rstd * g.z * (1.f + sc.z) + sh.z, o3 = v[j].w * rstd * g.w * (1.f + sc.w) + sh.w;
            uint2 w; w.x = pk2(o0, o1); w.y = pk2(o2, o3);
            *(uint2*)(H + (size_t)t * D_ + k) = w;
        }
    }
}

template <int NT>
__device__ __forceinline__ void wave_gemm(const bf16_t* arow, const bf16_t* const (&bcol)[NT], int K, f32x4 (&acc)[NT]) {
    const int g = (tidx() & 63) >> 4;
#pragma unroll
    for (int n = 0; n < NT; ++n) acc[n] = (f32x4){0.f, 0.f, 0.f, 0.f};
    for (int k0 = 0; k0 < K; k0 += 32) {
        const bf16x8 a = *(const bf16x8*)(arow + k0 + 8 * g);
#pragma unroll
        for (int n = 0; n < NT; ++n) {
            const bf16x8 b = *(const bf16x8*)(bcol[n] + k0 + 8 * g);
            acc[n] = __builtin_amdgcn_mfma_f32_16x16x32_bf16(a, b, acc[n], 0, 0, 0);
        }
    }
}


namespace pg8 {
constexpr int BM = 256, BK = 64, HALF = 128, HTB = HALF * BK * 2, STAGE_BYTES = 8 * HTB, NXCD = 8, WGM = 8;
constexpr int KD = 1024, NKT = KD / BK;
__device__ __forceinline__ int lds_byte(int r, int c) { const int st = (r >> 4) * 2 + (c >> 5), rr = r & 15, cc = c & 31, ob = rr * 64 + cc * 2; return st * 1024 + (ob ^ (((ob >> 9) & 1) << 5)); }
__device__ __forceinline__ void stage_rc(int b, int& R, int& C) { const int st = b / 1024, sb = b % 1024, swz = sb ^ (((sb >> 9) & 1) << 5); R = (st >> 1) * 16 + swz / 64; C = (st & 1) * 32 + (swz % 64) / 2; }
__device__ __forceinline__ int perm32(int rho) { const int n = rho >> 4, i = rho & 15; return 8 * (i >> 2) + 4 * n + (i & 3); }
struct Unit { int e, pm, pn, ui; };
__device__ __forceinline__ unsigned cvt_pk_bf16(float lo, float hi) { return pk2(lo, hi); }

__device__ __forceinline__ bool static_map(long L, int nM, int nN, Unit& u);
__device__ __forceinline__ bool static_next(int i, int G, int c, int nM, int nN, Unit& u) { const bool ok = static_map((long)i * G + c, nM, nN, u); u.ui = i; return ok; }
__device__ __forceinline__ bool static_map(long L, int nM, int nN, Unit& u) {
    const int nwg = nM * nN; if (L >= nwg) return false;
    int wgid = (int)L; { const int q = nwg / NXCD, r = nwg % NXCD, xcd = wgid % NXCD, off = wgid / NXCD; wgid = (xcd < r ? xcd * (q + 1) : r * (q + 1) + (xcd - r) * q) + off; }
    const int nig = WGM * nN, gid = wgid / nig, fm = gid * WGM, gsz = (nM - fm) < WGM ? (nM - fm) : WGM;
    u.pm = fm + ((wgid % nig) % gsz); u.pn = (wgid % nig) / gsz; u.e = 0; u.ui = 0; return true;
}

template <class Prob>
__device__ __forceinline__ void gemm_phase(LAS unsigned char* lds, const Prob& P) {
    const int tid = tidx(), wid = __builtin_amdgcn_readfirstlane(tid >> 6), lane = tid & 63, wr = wid >> 2, wc = wid & 3, fr = lane & 15, fq = lane >> 4;
    unsigned voffA[2], voffB[2];
#pragma unroll
    for (int i = 0; i < 2; ++i) { int R, C; stage_rc(tid * 16 + i * 8192, R, C); const int Rb = Prob::PERM ? ((R & ~31) + perm32(R & 31)) : R; voffA[i] = (unsigned)(R * KD + C) * 2u; voffB[i] = (unsigned)(Rb * KD + C) * 2u; }
    const unsigned ldsw = (unsigned)wid * 1024u;
    const int aoff = lds_byte(wr * 64 + fr, fq * 8), boff = lds_byte(wc * 32 + fr, fq * 8);
#define PG8_SA(b, h) (((b) * 2 + (h)) * HTB)
#define PG8_SB(b, h) ((4 + (b) * 2 + (h)) * HTB)
#define PG8_STAGE_B(bufoff, gbase) do { _Pragma("unroll") for (int _i = 0; _i < 2; ++_i) \
        __builtin_amdgcn_global_load_lds((const unsigned*)((const char*)(gbase) + voffB[_i]), (LAS unsigned*)(lds + (bufoff) + ldsw + _i * 8192), 16, 0, 0); } while (0)
#define PG8_STAGE_A(bufoff, gbase) do { _Pragma("unroll") for (int _i = 0; _i < 2; ++_i) \
        __builtin_amdgcn_global_load_lds((const unsigned*)((const char*)(gbase) + voffA[_i]), (LAS unsigned*)(lds + (bufoff) + ldsw + _i * 8192), 16, 0, 0); } while (0)
#define PG8_LDA(dst, b, h) do { _Pragma("unroll") for (int m = 0; m < 4; ++m) _Pragma("unroll") for (int k = 0; k < 2; ++k) dst[m][k] = *(const LAS bf16x8*)(lds + PG8_SA(b, h) + aoff + m * 2048 + k * 1024); } while (0)
#define PG8_LDB(dst, b, h) do { _Pragma("unroll") for (int n = 0; n < 2; ++n) _Pragma("unroll") for (int k = 0; k < 2; ++k) dst[n][k] = *(const LAS bf16x8*)(lds + PG8_SB(b, h) + boff + n * 2048 + k * 1024); } while (0)
#define PG8_MMA(ai, bj, At, Bt) do { __builtin_amdgcn_s_setprio(1); _Pragma("unroll") for (int m = 0; m < 4; ++m) _Pragma("unroll") for (int n = 0; n < 2; ++n) _Pragma("unroll") for (int k = 0; k < 2; ++k) \
        acc[ai][bj][m][n] = __builtin_amdgcn_mfma_f32_16x16x32_bf16(Bt[n][k], At[m][k], acc[ai][bj][m][n], 0, 0, 0); __builtin_amdgcn_s_setprio(0); } while (0)
#define PG8_WAIT_V(n) asm volatile("s_waitcnt vmcnt(" #n ")" ::: "memory")
#define PG8_WAIT_L(n) asm volatile("s_waitcnt lgkmcnt(" #n ")" ::: "memory")
#define PG8_BAR __builtin_amdgcn_s_barrier()
#define PG8_SCHED __builtin_amdgcn_sched_barrier(0)
    Unit cur, nxt; int ui = 0;
    if (!P.next(0, cur)) return;
    f32x4 acc[2][2][4][2];
#pragma unroll
    for (int a = 0; a < 2; ++a)
#pragma unroll
        for (int b = 0; b < 2; ++b)
#pragma unroll
            for (int m = 0; m < 4; ++m)
#pragma unroll
                for (int n = 0; n < 2; ++n) acc[a][b][m][n] = (f32x4){0.f, 0.f, 0.f, 0.f};
    bf16x8 At[4][2], B0[2][2], B1[2][2];
    const size_t bh = P.b_hstep();
    constexpr size_t ah = (size_t)HALF * KD * 2;
    const char* cA = P.a_tile(cur);
    const char* cB = P.b_base(cur);
    PG8_STAGE_B(PG8_SB(0, 0), cB); PG8_STAGE_B(PG8_SB(0, 1), cB + bh); PG8_STAGE_A(PG8_SA(0, 0), cA); PG8_STAGE_A(PG8_SA(0, 1), cA + ah);
    if (wr == 1) PG8_BAR;
    PG8_WAIT_V(2); PG8_BAR;
    PG8_STAGE_B(PG8_SB(1, 0), cB + BK * 2); PG8_STAGE_A(PG8_SA(1, 0), cA + BK * 2); PG8_STAGE_B(PG8_SB(1, 1), cB + bh + BK * 2);
    PG8_WAIT_V(6); PG8_BAR;
    for (;;) {
        const bool has_next = P.next(ui + 1, nxt);
        const char* nA = has_next ? P.a_tile(nxt) : cA;
        const char* nB = has_next ? P.b_base(nxt) : cB;
        for (int t = 0; t < NKT; t += 2) {
            const bool last = (t == NKT - 2);
            const char* a1 = cA + (size_t)(t + 1) * (BK * 2);
            const char* a2 = last ? nA : cA + (size_t)(t + 2) * (BK * 2); const char* a3 = a2 + BK * 2;
            const char* b2 = last ? nB : cB + (size_t)(t + 2) * (BK * 2); const char* b3 = b2 + BK * 2;
            PG8_LDB(B0, 0, 0); PG8_LDB(B1, 0, 1); PG8_SCHED; PG8_LDA(At, 0, 0); PG8_STAGE_A(PG8_SA(1, 1), a1 + ah);
            PG8_WAIT_V(8); PG8_WAIT_L(0); PG8_BAR; PG8_MMA(0, 0, At, B0); PG8_MMA(0, 1, At, B1); PG8_BAR; PG8_SCHED;
            PG8_LDA(At, 0, 1); PG8_STAGE_B(PG8_SB(0, 0), b2); PG8_STAGE_B(PG8_SB(0, 1), b2 + bh); PG8_STAGE_A(PG8_SA(0, 0), a2);
            PG8_WAIT_V(8); PG8_WAIT_L(0); PG8_BAR; PG8_MMA(1, 0, At, B0); PG8_MMA(1, 1, At, B1); PG8_BAR; PG8_SCHED;
            PG8_LDB(B0, 1, 0); PG8_LDB(B1, 1, 1); PG8_SCHED; PG8_LDA(At, 1, 0); PG8_STAGE_A(PG8_SA(0, 1), a2 + ah);
            PG8_WAIT_V(8); PG8_WAIT_L(0); PG8_BAR; PG8_MMA(0, 0, At, B0); PG8_MMA(0, 1, At, B1); PG8_BAR; PG8_SCHED;
            PG8_LDA(At, 1, 1); PG8_STAGE_B(PG8_SB(1, 0), b3); PG8_STAGE_B(PG8_SB(1, 1), b3 + bh); PG8_STAGE_A(PG8_SA(1, 0), a3);
            PG8_WAIT_V(8); PG8_WAIT_L(0); PG8_BAR; PG8_MMA(1, 0, At, B0); PG8_MMA(1, 1, At, B1); PG8_BAR; PG8_SCHED;
        }
        PG8_WAIT_V(0);
        if (wr == 0) PG8_BAR;
        P.epi(acc, cur, wr, wc, fr, fq);
        if (PROBE_EPI) P.epi(acc, cur, wr, wc, fr, fq);
        if (!has_next) break;
#pragma unroll
        for (int a = 0; a < 2; ++a)
#pragma unroll
            for (int b = 0; b < 2; ++b)
#pragma unroll
                for (int m = 0; m < 4; ++m)
#pragma unroll
                    for (int n = 0; n < 2; ++n) acc[a][b][m][n] = (f32x4){0.f, 0.f, 0.f, 0.f};
        cur = nxt; cA = nA; cB = nB; ++ui;
        if (wr == 1) PG8_BAR;
    }
    PG8_WAIT_V(0);
    PG8_BAR;
#undef PG8_SA
#undef PG8_SB
#undef PG8_STAGE_A
#undef PG8_STAGE_B
#undef PG8_LDA
#undef PG8_LDB
#undef PG8_MMA
#undef PG8_WAIT_V
#undef PG8_WAIT_L
#undef PG8_BAR
#undef PG8_SCHED
}
}

template <bool F8>
struct ProbInProjT {
    static constexpr bool PERM = true;
    const char* A; const char* Bt; bf16_t* PROJ; const float* cs; const float* lbt; int G, c; LAS float* lbl;
    __device__ __forceinline__ bool next(int i, pg8::Unit& u) const {
        bool ok;
        if (F8) {
            long L;
            if (G == 256) { if (i < 5) L = (long)i * 256 + c; else if (c >= 128 && i < 7) L = 1280 + (c - 128) * 2 + (i - 5); else return false; }
            else L = (long)i * G + c;
            ok = pg8::static_map(L, T_ / 256, 12, u);
        } else {
            long L;
            if (G == 256) { if (i == 0) L = c; else if (i == 1 && c < 128) L = 256 + c; else return false; }
            else L = (long)i * G + c;
            ok = pg8::static_map(L, T_ / 256, 3, u); u.pn += 12;
        }
        u.ui = i; return ok;
    }
    __device__ __forceinline__ const char* a_base() const { return A; }
    __device__ __forceinline__ const char* a_tile(const pg8::Unit& u) const { return A + (size_t)u.pm * 256 * 1024 * 2; }
    __device__ __forceinline__ size_t b_hstep() const { return (size_t)128 * 1024 * (F8 ? 1 : 2); }
    __device__ __forceinline__ const char* b_base(const pg8::Unit& u) const { return Bt + (size_t)u.pn * 256 * 1024 * (F8 ? 1 : 2); }
    __device__ __forceinline__ void a_off(const pg8::Unit& u, const int (&R)[2], const int (&C)[2], unsigned (&off)[2][2]) const {
#pragma unroll
        for (int h = 0; h < 2; ++h)
#pragma unroll
            for (int i = 0; i < 2; ++i) off[h][i] = F8 ? (unsigned)((u.pm * 256 + 128 * h + R[i]) * 1024 + 2 * C[i]) : (unsigned)((u.pm * 256 + 128 * h + R[i]) * 1024 + C[i]) * 2u;
    }
    __device__ __forceinline__ void epi(const f32x4 (&acc)[2][2][4][2], const pg8::Unit& u, int wr, int wc, int fr, int fq) const {
        const int type = u.pn < 3 ? 0 : (u.pn < 6 ? 1 : (u.pn < 9 ? 2 : (u.pn < 12 ? 3 : (u.pn < 14 ? 4 : 5))));
        const int colb = u.pn * 256 + wc * 32 + 8 * fq;
        f32x4 lbv[2][2];
        if (type == 1) {
#pragma unroll
            for (int bj = 0; bj < 2; ++bj) { if (F8) { lbv[bj][0] = *(const LAS f32x4*)(lbl + colb + 128 * bj - C_HF); lbv[bj][1] = *(const LAS f32x4*)(lbl + colb + 128 * bj - C_HF + 4); }
                else { lbv[bj][0] = *(const f32x4*)(lbt + colb + 128 * bj - C_HF); lbv[bj][1] = *(const f32x4*)(lbt + colb + 128 * bj - C_HF + 4); } }
        }
        const bool rot = (type == 4) && ((wc & 1) == 0) && (fq < 2);
#pragma unroll
        for (int ai = 0; ai < 2; ++ai)
#pragma unroll
            for (int m = 0; m < 4; ++m) {
                const int t = u.pm * 256 + ai * 128 + wr * 64 + m * 16 + fr;
                bf16_t* rowp = PROJ + (size_t)t * NPROJ + colb;
                f32x4 cv[2], sv[2];
                if (type == 4) { cv[0] = *(const f32x4*)(cs + t * 16); cv[1] = *(const f32x4*)(cs + t * 16 + 4); sv[0] = *(const f32x4*)(cs + t * 16 + 8); sv[1] = *(const f32x4*)(cs + t * 16 + 12); }
#pragma unroll
                for (int bj = 0; bj < 2; ++bj) {
                    f32x4 v[2] = {acc[ai][bj][m][0], acc[ai][bj][m][1]};
                    constexpr float WS = F8 ? W8_INV : 1.f, L2E = 1.4426950408889634f;
                    if (type == 0) {
#pragma unroll
                        for (int n = 0; n < 2; ++n)
#pragma unroll
                            for (int j = 0; j < 4; ++j) { const float a = v[n][j]; v[n][j] = (a * (WS * 0.08838834764831845f)) * __builtin_amdgcn_rcpf(1.f + __builtin_amdgcn_exp2f(a * (-WS * L2E))); }
                    } else if (type == 1) {
#pragma unroll
                        for (int n = 0; n < 2; ++n)
#pragma unroll
                            for (int j = 0; j < 4; ++j) { const float lb = lbv[bj][n][j]; const float sg = __builtin_amdgcn_rcpf(1.f + __builtin_amdgcn_exp2f(v[n][j] * (-WS * L2E)));
                                v[n][j] = __builtin_amdgcn_logf(__builtin_fmaf(1.f - lb, sg, lb)) * 0.6931471805599453f; }
                    } else if (type == 3) {
#pragma unroll
                        for (int n = 0; n < 2; ++n)
#pragma unroll
                            for (int j = 0; j < 4; ++j) { const float a = v[n][j]; v[n][j] = (a * WS) * __builtin_amdgcn_rcpf(1.f + __builtin_amdgcn_exp2f(a * (-WS * L2E))); }
                    } else if (F8) { v[0] = v[0] * W8_INV; v[1] = v[1] * W8_INV; }
                    if (type == 4) {
#pragma unroll
                        for (int n = 0; n < 2; ++n)
#pragma unroll
                            for (int j = 0; j < 4; ++j) {
                                const float partner = __shfl_xor(v[n][j], 16);
                                const float r0 = v[n][j] * cv[n][j] - partner * sv[n][j], r1 = v[n][j] * cv[n][j] + partner * sv[n][j];
                                if (rot) v[n][j] = (fq == 0) ? r0 : r1;
                            }
                    }
                    u32x4 w; w.x = pg8::cvt_pk_bf16(v[0][0], v[0][1]); w.y = pg8::cvt_pk_bf16(v[0][2], v[0][3]); w.z = pg8::cvt_pk_bf16(v[1][0], v[1][1]); w.w = pg8::cvt_pk_bf16(v[1][2], v[1][3]);
                    *(u32x4*)(rowp + bj * 128) = w;
                }
            }
    }
};

struct ProbInProjFull : ProbInProjT<false> {
    __device__ __forceinline__ bool next(int i, pg8::Unit& u) const { return pg8::static_next(i, G, c, T_ / 256, NPROJ / 256, u); }
};
struct ProbOutProj {
    static constexpr bool PERM = true;
    const char* A; const char* Bt; const float* x; bf16_t* x1b; const float* mod; int G, c;
    __device__ __forceinline__ bool next(int i, pg8::Unit& u) const { return pg8::static_next(i, G, c, T_ / 256, D_ / 256, u); }
    __device__ __forceinline__ const char* a_base() const { return A; }
    __device__ __forceinline__ const char* a_tile(const pg8::Unit& u) const { return A + (size_t)u.pm * 256 * 1024 * 2; }
    __device__ __forceinline__ size_t b_hstep() const { return (size_t)128 * 1024 * 2; }
    __device__ __forceinline__ const char* b_base(const pg8::Unit& u) const { return Bt + (size_t)u.pn * 256 * 1024 * 2; }
    __device__ __forceinline__ void a_off(const pg8::Unit& u, const int (&R)[2], const int (&C)[2], unsigned (&off)[2][2]) const {
#pragma unroll
        for (int h = 0; h < 2; ++h)
#pragma unroll
            for (int i = 0; i < 2; ++i) off[h][i] = (unsigned)((u.pm * 256 + 128 * h + R[i]) * 1024 + C[i]) * 2u;
    }
    __device__ __forceinline__ void epi(const f32x4 (&acc)[2][2][4][2], const pg8::Unit& u, int wr, int wc, int fr, int fq) const {
        const int b = (u.pm * 256) / S_;
        const int col0 = u.pn * 256 + wc * 32 + 8 * fq;
        f32x4 gv[2][2];
#pragma unroll
        for (int bj = 0; bj < 2; ++bj)
#pragma unroll
            for (int n = 0; n < 2; ++n) gv[bj][n] = *(const f32x4*)(mod + b * NMOD + 2 * D_ + col0 + bj * 128 + n * 4);
#pragma unroll
        for (int ai = 0; ai < 2; ++ai)
#pragma unroll
            for (int mp = 0; mp < 4; mp += 2) {
                f32x4 xs[2][2][2];
#pragma unroll
                for (int mm = 0; mm < 2; ++mm) { const size_t off = (size_t)(u.pm * 256 + ai * 128 + wr * 64 + (mp + mm) * 16 + fr) * D_ + col0;
#pragma unroll
                    for (int bj = 0; bj < 2; ++bj) { xs[mm][bj][0] = *(const f32x4*)(x + off + bj * 128); xs[mm][bj][1] = *(const f32x4*)(x + off + bj * 128 + 4); } }
#pragma unroll
                for (int mm = 0; mm < 2; ++mm) { const int m = mp + mm; const size_t off = (size_t)(u.pm * 256 + ai * 128 + wr * 64 + m * 16 + fr) * D_ + col0;
#pragma unroll
                    for (int bj = 0; bj < 2; ++bj) {
                        const f32x4 v0 = xs[mm][bj][0] + gv[bj][0] * acc[ai][bj][m][0], v1 = xs[mm][bj][1] + gv[bj][1] * acc[ai][bj][m][1];
                        u32x4 w; w.x = pk2(v0[0], v0[1]); w.y = pk2(v0[2], v0[3]); w.z = pk2(v1[0], v1[1]); w.w = pk2(v1[2], v1[3]);
                        *(u32x4*)(x1b + off + bj * 128) = w;
                    } }
                asm volatile("" ::: "memory");
            }
    }
};

constexpr int MOE_TAB_OFF = pg8::STAGE_BYTES + 256;
constexpr int MOE_MAXU = 18;
constexpr int MOE_BIAS_OFF = MOE_TAB_OFF + MOE_MAXU * 256 * 4;
template <int GEMM  >
struct ProbMoE {
    static constexpr bool PERM = true;
    static constexpr int GM = (GEMM == 1) ? 4 : 8, GN = (GEMM == 1) ? 8 : 4;
    const char* A; const char* Bt; bf16_t* O; const float* bias; const float* gate; const unsigned* ecnt; const int* elist;
    LAS int* pre; LAS int* tab; int G, c;
    __device__ __forceinline__ bool next(int i, pg8::Unit& u) const {
        const int v = (G % 8 == 0) ? (c % 8) * (G / 8) + c / 8 : c;
        const int Lv = i * G + v, grp = Lv / (GM * GN), within = Lv % (GM * GN);
        const int g = grp * GM + within / GN;
        if (g >= pre[NE_] || i >= MOE_MAXU) return false;
        int e = 0; while (pre[e + 1] <= g) ++e;
        u.e = e; u.pm = g - pre[e]; u.pn = within % GN; u.ui = i; return true;
    }
    __device__ __forceinline__ void fill_tab() const {
        for (int idx = tidx(); idx < MOE_MAXU * 256; idx += NTHREADS) {
            const int ui = idx >> 8, r = idx & 255; pg8::Unit u;
            int val = -1;
            if (next(ui, u)) { const int cnt = (int)ecnt[u.e], li = u.pm * 256 + r; val = (li < cnt) ? elist[u.e * 32768 + li] : (-elist[u.e * 32768 + u.pm * 256] - 1); }
            tab[idx] = val;
        }
    }
    __device__ __forceinline__ const char* a_base() const { return A; }
    __device__ __forceinline__ size_t b_hstep() const { return (GEMM == 1) ? (size_t)1024 * 1024 * 2 : (size_t)128 * 1024 * 2; }
    __device__ __forceinline__ const char* b_base(const pg8::Unit& u) const {
        return (GEMM == 1) ? Bt + ((size_t)u.e * 2048 + (size_t)u.pn * 128) * 1024 * 2 : Bt + ((size_t)u.e * 1024 + (size_t)u.pn * 256) * 1024 * 2;
    }
    __device__ __forceinline__ void a_off(const pg8::Unit& u, const int (&R)[2], const int (&C)[2], unsigned (&off)[2][2]) const {
#pragma unroll
        for (int h = 0; h < 2; ++h)
#pragma unroll
            for (int i = 0; i < 2; ++i) { int en = tab[u.ui * 256 + 128 * h + R[i]]; en = en < 0 ? (-en - 1) : en; const int row = (GEMM == 1) ? (en >> 2) : en; off[h][i] = (unsigned)(row * 1024 + C[i]) * 2u; }
    }
    __device__ __forceinline__ void epi(const f32x4 (&acc)[2][2][4][2], const pg8::Unit& u, int wr, int wc, int fr, int fq) const {
        if (GEMM == 1) {
            const int c0 = u.pn * 128 + wc * 32 + 8 * fq;
            const f32x4 bg0 = *(const f32x4*)(bias + u.e * 2048 + c0), bg1 = *(const f32x4*)(bias + u.e * 2048 + c0 + 4);
            const f32x4 bu0 = *(const f32x4*)(bias + u.e * 2048 + 1024 + c0), bu1 = *(const f32x4*)(bias + u.e * 2048 + 1024 + c0 + 4);
#pragma unroll
            for (int ai = 0; ai < 2; ++ai)
#pragma unroll
                for (int m = 0; m < 4; ++m) {
                    const int en = tab[u.ui * 256 + ai * 128 + wr * 64 + m * 16 + fr];
                    f32x4 g0 = acc[ai][0][m][0] + bg0, g1 = acc[ai][0][m][1] + bg1, u0 = acc[ai][1][m][0] + bu0, u1 = acc[ai][1][m][1] + bu1;
                    float a[8];
#pragma unroll
                    for (int j = 0; j < 4; ++j) {
                        const float gv0 = fminf(g0[j], 7.f), uv0 = fminf(fmaxf(u0[j], -7.f), 7.f); a[j] = (uv0 + 1.f) * gv0 * sigmoidf_(1.702f * gv0);
                        const float gv1 = fminf(g1[j], 7.f), uv1 = fminf(fmaxf(u1[j], -7.f), 7.f); a[4 + j] = (uv1 + 1.f) * gv1 * sigmoidf_(1.702f * gv1);
                    }
                    if (en >= 0) { u32x4 w; w.x = pg8::cvt_pk_bf16(a[0], a[1]); w.y = pg8::cvt_pk_bf16(a[2], a[3]); w.z = pg8::cvt_pk_bf16(a[4], a[5]); w.w = pg8::cvt_pk_bf16(a[6], a[7]);
                        *(u32x4*)(O + (size_t)en * DFF_ + c0) = w; }
                }
        } else {
            const int c0 = u.pn * 256 + wc * 32 + 8 * fq;
            f32x4 bv[2][2];
#pragma unroll
            for (int bj = 0; bj < 2; ++bj) { bv[bj][0] = *(const f32x4*)(bias + u.e * 1024 + c0 + 128 * bj); bv[bj][1] = *(const f32x4*)(bias + u.e * 1024 + c0 + 128 * bj + 4); }
#pragma unroll
            for (int ai = 0; ai < 2; ++ai)
#pragma unroll
                for (int m = 0; m < 4; ++m) {
                    const int en = tab[u.ui * 256 + ai * 128 + wr * 64 + m * 16 + fr];
                    if (en >= 0) {
                        const float gt = gate[en];
#pragma unroll
                        for (int bj = 0; bj < 2; ++bj) { const f32x4 v0 = (acc[ai][bj][m][0] + bv[bj][0]) * gt, v1 = (acc[ai][bj][m][1] + bv[bj][1]) * gt;
                            u32x4 w; w.x = pg8::cvt_pk_bf16(v0[0], v0[1]); w.y = pg8::cvt_pk_bf16(v0[2], v0[3]); w.z = pg8::cvt_pk_bf16(v1[0], v1[1]); w.w = pg8::cvt_pk_bf16(v1[2], v1[3]);
                            *(u32x4*)(O + (size_t)en * D_ + c0 + 128 * bj) = w; }
                    }
                }
        }
    }
};


namespace pg8 {
typedef int i32x8 __attribute__((ext_vector_type(8)));
typedef int i32x4 __attribute__((ext_vector_type(4)));
template <class Prob>
__device__ __forceinline__ void gemm_phase8(LAS unsigned char* lds, const Prob& P) {
    constexpr int ROWB = 1024, NKT8 = ROWB / 128;
    const int tid = tidx(), wid = __builtin_amdgcn_readfirstlane(tid >> 6), lane = tid & 63, wr = wid >> 2, wc = wid & 3, fr = lane & 15, fq = lane >> 4;
    int R[2], Cc[2]; unsigned voffB[2];
#pragma unroll
    for (int i = 0; i < 2; ++i) { stage_rc(tid * 16 + i * 8192, R[i], Cc[i]); const int Rb = Prob::PERM ? ((R[i] & ~31) + perm32(R[i] & 31)) : R[i]; voffB[i] = (unsigned)(Rb * ROWB + 2 * Cc[i]); }
    const unsigned ldsw = (unsigned)wid * 1024u;
    const int aoff0 = lds_byte(wr * 64 + fr, fq * 8), boff0 = lds_byte(wc * 32 + fr, fq * 8);
#define PG8_SA(b, h) (((b) * 2 + (h)) * HTB)
#define PG8_SB(b, h) ((4 + (b) * 2 + (h)) * HTB)
#define PG8_STAGE_B(bufoff, gbase) do { _Pragma("unroll") for (int _i = 0; _i < 2; ++_i) \
        __builtin_amdgcn_global_load_lds((const unsigned*)((const char*)(gbase) + voffB[_i]), (LAS unsigned*)(lds + (bufoff) + ldsw + _i * 8192), 16, 0, 0); } while (0)
#define PG8_STAGE_A(bufoff, o, kb) do { _Pragma("unroll") for (int _i = 0; _i < 2; ++_i) \
        __builtin_amdgcn_global_load_lds((const unsigned*)(Ab + ((o)[_i] + (unsigned)(kb))), (LAS unsigned*)(lds + (bufoff) + ldsw + _i * 8192), 16, 0, 0); } while (0)
#define PG8_CAT(x, y) __builtin_shufflevector((x), (y), 0, 1, 2, 3, 4, 5, 6, 7)
#define PG8_LDA(dst, b, h) do { _Pragma("unroll") for (int m = 0; m < 4; ++m) { dst[m].lo = *(const LAS i32x4*)(lds + PG8_SA(b, h) + aoff0 + m * 2048); dst[m].hi = *(const LAS i32x4*)(lds + PG8_SA(b, h) + aoff0 + m * 2048 + 1024); } } while (0)
#define PG8_LDB(dst, b, h) do { _Pragma("unroll") for (int n = 0; n < 2; ++n) { dst[n].lo = *(const LAS i32x4*)(lds + PG8_SB(b, h) + boff0 + n * 2048); dst[n].hi = *(const LAS i32x4*)(lds + PG8_SB(b, h) + boff0 + n * 2048 + 1024); } } while (0)
#define PG8_MMA(ai, bj, At, Bt) do { __builtin_amdgcn_s_setprio(1); _Pragma("unroll") for (int m = 0; m < 4; ++m) _Pragma("unroll") for (int n = 0; n < 2; ++n) \
        asm volatile("v_mfma_f32_16x16x128_f8f6f4 %0, %1, %2, %0" : "+v"(acc[ai][bj][m][n]) : "v"(Bt[n]), "v"(At[m])); __builtin_amdgcn_s_setprio(0); } while (0)
#define PG8_WAIT_V(n) asm volatile("s_waitcnt vmcnt(" #n ")" ::: "memory")
#define PG8_WAIT_L(n) asm volatile("s_waitcnt lgkmcnt(" #n ")" ::: "memory")
#define PG8_BAR __builtin_amdgcn_s_barrier()
#define PG8_SCHED __builtin_amdgcn_sched_barrier(0)
    Unit cur, nxt; int ui = 0;
    if (!P.next(0, cur)) return;
    f32x4 acc[2][2][4][2];
#pragma unroll
    for (int a = 0; a < 2; ++a)
#pragma unroll
        for (int b = 0; b < 2; ++b)
#pragma unroll
            for (int m = 0; m < 4; ++m)
#pragma unroll
                for (int n = 0; n < 2; ++n) acc[a][b][m][n] = (f32x4){0.f, 0.f, 0.f, 0.f};
#define PG8_PIN_ACC() do { _Pragma("unroll") for (int a = 0; a < 2; ++a) _Pragma("unroll") for (int b = 0; b < 2; ++b) _Pragma("unroll") for (int m = 0; m < 4; ++m) _Pragma("unroll") for (int n = 0; n < 2; ++n) asm volatile("" : "+v"(acc[a][b][m][n])); } while (0)
    PG8_PIN_ACC();
    i32x8 At[4], B0[2], B1[2];
    int sc1 = 0x7F7F7F7F; asm volatile("" : "+v"(sc1));
    const char* Ab = P.a_base();
    const size_t bh = P.b_hstep();
    unsigned aoc[2][2], aon[2][2];
    P.a_off(cur, R, Cc, aoc);
    const char* cB = P.b_base(cur);
    PG8_STAGE_B(PG8_SB(0, 0), cB); PG8_STAGE_B(PG8_SB(0, 1), cB + bh); PG8_STAGE_A(PG8_SA(0, 0), aoc[0], 0); PG8_STAGE_A(PG8_SA(0, 1), aoc[1], 0);
    if (wr == 1) PG8_BAR;
    PG8_WAIT_V(2); PG8_BAR;
    PG8_STAGE_B(PG8_SB(1, 0), cB + 128); PG8_STAGE_A(PG8_SA(1, 0), aoc[0], 128); PG8_STAGE_B(PG8_SB(1, 1), cB + bh + 128);
    PG8_WAIT_V(6); PG8_BAR;
    for (;;) {
        const bool has_next = P.next(ui + 1, nxt);
        if (has_next) P.a_off(nxt, R, Cc, aon);
        else { aon[0][0] = aoc[0][0]; aon[0][1] = aoc[0][1]; aon[1][0] = aoc[1][0]; aon[1][1] = aoc[1][1]; }
        const char* nB = has_next ? P.b_base(nxt) : cB;
        for (int t = 0; t < NKT8; t += 2) {
            constexpr bool fresh = false;
            const bool last = (t == NKT8 - 2);
            const unsigned k1 = (unsigned)(t + 1) * 128u;
            const unsigned k2 = last ? 0u : (unsigned)(t + 2) * 128u, k3 = k2 + 128u;
            unsigned o2[2][2];
            o2[0][0] = last ? aon[0][0] : aoc[0][0]; o2[0][1] = last ? aon[0][1] : aoc[0][1];
            o2[1][0] = last ? aon[1][0] : aoc[1][0]; o2[1][1] = last ? aon[1][1] : aoc[1][1];
            const char* b2 = last ? nB : cB + (size_t)(t + 2) * 128; const char* b3 = b2 + 128;
            PG8_LDB(B0, 0, 0); PG8_LDB(B1, 0, 1); PG8_SCHED; PG8_LDA(At, 0, 0); PG8_STAGE_A(PG8_SA(1, 1), aoc[1], k1);
            if (!fresh) PG8_WAIT_V(8); PG8_WAIT_L(0); PG8_BAR; PG8_MMA(0, 0, At, B0); PG8_MMA(0, 1, At, B1); PG8_BAR; PG8_SCHED;
            PG8_LDA(At, 0, 1); PG8_STAGE_B(PG8_SB(0, 0), b2); PG8_STAGE_B(PG8_SB(0, 1), b2 + bh); PG8_STAGE_A(PG8_SA(0, 0), o2[0], k2);
            if (!fresh) PG8_WAIT_V(8); PG8_WAIT_L(0); PG8_BAR; PG8_MMA(1, 0, At, B0); PG8_MMA(1, 1, At, B1); PG8_BAR; PG8_SCHED;
            PG8_LDB(B0, 1, 0); PG8_LDB(B1, 1, 1); PG8_SCHED; PG8_LDA(At, 1, 0); PG8_STAGE_A(PG8_SA(0, 1), o2[1], k2);
            PG8_WAIT_V(8); PG8_WAIT_L(0); PG8_BAR; PG8_MMA(0, 0, At, B0); PG8_MMA(0, 1, At, B1); PG8_BAR; PG8_SCHED;
            PG8_LDA(At, 1, 1); PG8_STAGE_B(PG8_SB(1, 0), b3); PG8_STAGE_B(PG8_SB(1, 1), b3 + bh); PG8_STAGE_A(PG8_SA(1, 0), o2[0], k3);
            PG8_WAIT_V(8); PG8_WAIT_L(0); PG8_BAR; PG8_MMA(1, 0, At, B0); PG8_MMA(1, 1, At, B1); PG8_BAR; PG8_SCHED;
        }
        asm volatile("s_nop 15\n\ts_nop 15" ::: "memory");
        if (wr == 0) PG8_BAR;
        P.epi(acc, cur, wr, wc, fr, fq);
        if (PROBE_EPI) P.epi(acc, cur, wr, wc, fr, fq);
        if (!has_next) break;
#pragma unroll
        for (int a = 0; a < 2; ++a)
#pragma unroll
            for (int b = 0; b < 2; ++b)
#pragma unroll
                for (int m = 0; m < 4; ++m)
#pragma unroll
                    for (int n = 0; n < 2; ++n) acc[a][b][m][n] = (f32x4){0.f, 0.f, 0.f, 0.f};
        PG8_PIN_ACC();
        cur = nxt; cB = nB; ++ui;
        aoc[0][0] = aon[0][0]; aoc[0][1] = aon[0][1]; aoc[1][0] = aon[1][0]; aoc[1][1] = aon[1][1];
        if (wr == 1) PG8_BAR;
    }
    PG8_WAIT_V(0);
    PG8_BAR;
#undef PG8_SA
#undef PG8_SB
#undef PG8_STAGE_A
#undef PG8_STAGE_B
#undef PG8_CAT
#undef PG8_LDA
#undef PG8_LDB
#undef PG8_MMA
#undef PG8_WAIT_V
#undef PG8_WAIT_L
#undef PG8_BAR
#undef PG8_SCHED
}
}


template <int GEMM  >
struct ProbMoE8 {
    static constexpr bool PERM = true;
    static constexpr int GM = (GEMM == 1) ? 4 : 8, GN = (GEMM == 1) ? 8 : 4;
    const char* A; const char* Bt; unsigned char* O; const float* bias; const float* gate; const unsigned* ecnt; const int* elist;
    LAS int* pre; LAS int* tab; LAS int* uinf; LAS bf16_t* biasl; int G, c;
    __device__ __forceinline__ bool next_slow(int i, pg8::Unit& u) const {
        const int v = (G % 8 == 0) ? (c % 8) * (G / 8) + c / 8 : c;
        const int Lv = i * G + v, grp = Lv / (GM * GN), within = Lv % (GM * GN);
        const int g = grp * GM + within / GN;
        if (g >= pre[NE_] || i >= MOE_MAXU) return false;
        int e = 0; while (pre[e + 1] <= g) ++e;
        u.e = e; u.pm = g - pre[e]; u.pn = within % GN; u.ui = i; return true;
    }
    __device__ __forceinline__ bool next(int i, pg8::Unit& u) const {
        if (i >= MOE_MAXU) return false;
        const int v = uinf[i]; if (v < 0) return false;
        u.e = v & 63; u.pm = (v >> 6) & 16383; u.pn = v >> 20; u.ui = i; return true;
    }
    __device__ __forceinline__ void fill_tab() const {
        if (tidx() < MOE_MAXU) { pg8::Unit u; uinf[tidx()] = next_slow(tidx(), u) ? (u.e | (u.pm << 6) | (u.pn << 20)) : -1; }
        __syncthreads();
        for (int idx = tidx(); idx < MOE_MAXU * 256; idx += NTHREADS) {
            const int ui = idx >> 8, r = idx & 255; pg8::Unit u;
            int val = -1;
            if (next(ui, u)) { const int cnt = (int)ecnt[u.e], li = u.pm * 256 + r; val = (li < cnt) ? elist[u.e * 32768 + li] : (-elist[u.e * 32768 + u.pm * 256] - 1); }
            tab[idx] = val;
        }
        for (int idx = tidx(); idx < MOE_MAXU * 256; idx += NTHREADS) {
            const int ui = idx >> 8, cc = idx & 255; pg8::Unit u; float bvv = 0.f;
            if (next(ui, u)) bvv = (GEMM == 1) ? bias[u.e * 2048 + (cc < 128 ? 0 : 1024) + u.pn * 128 + (cc & 127)] : bias[u.e * 1024 + u.pn * 256 + cc];
            biasl[idx] = f2bf(GEMM == 1 ? bvv : bvv * OUT2_SCALE);
        }
    }
    __device__ __forceinline__ const char* a_base() const { return A; }
    __device__ __forceinline__ size_t b_hstep() const { return (GEMM == 1) ? (size_t)1024 * 1024 : (size_t)128 * 1024; }
    __device__ __forceinline__ const char* b_base(const pg8::Unit& u) const {
        return (GEMM == 1) ? Bt + ((size_t)u.e * 2048 + (size_t)u.pn * 128) * 1024 : Bt + ((size_t)u.e * 1024 + (size_t)u.pn * 256) * 1024;
    }
    __device__ __forceinline__ void a_off(const pg8::Unit& u, const int (&R)[2], const int (&C)[2], unsigned (&off)[2][2]) const {
#pragma unroll
        for (int h = 0; h < 2; ++h)
#pragma unroll
            for (int i = 0; i < 2; ++i) { int en = tab[u.ui * 256 + 128 * h + R[i]]; en = en < 0 ? (-en - 1) : en; const int row = (GEMM == 1) ? (en >> 2) : en; off[h][i] = (unsigned)(row * 1024 + 2 * C[i]); }
    }
    __device__ __forceinline__ void epi(const f32x4 (&acc)[2][2][4][2], const pg8::Unit& u, int wr, int wc, int fr, int fq) const {
        if (GEMM == 1) {
            const int c0 = u.pn * 128 + wc * 32 + 8 * fq;
            const u32x4 bgw = *(const LAS u32x4*)(biasl + u.ui * 256 + wc * 32 + 8 * fq), buw = *(const LAS u32x4*)(biasl + u.ui * 256 + 128 + wc * 32 + 8 * fq);
            const f32x4 bg0 = (f32x4){__uint_as_float(bgw.x << 16), __uint_as_float(bgw.x & 0xffff0000u), __uint_as_float(bgw.y << 16), __uint_as_float(bgw.y & 0xffff0000u)};
            const f32x4 bg1 = (f32x4){__uint_as_float(bgw.z << 16), __uint_as_float(bgw.z & 0xffff0000u), __uint_as_float(bgw.w << 16), __uint_as_float(bgw.w & 0xffff0000u)};
            const f32x4 bu0 = (f32x4){__uint_as_float(buw.x << 16), __uint_as_float(buw.x & 0xffff0000u), __uint_as_float(buw.y << 16), __uint_as_float(buw.y & 0xffff0000u)};
            const f32x4 bu1 = (f32x4){__uint_as_float(buw.z << 16), __uint_as_float(buw.z & 0xffff0000u), __uint_as_float(buw.w << 16), __uint_as_float(buw.w & 0xffff0000u)};
#pragma unroll
            for (int ai = 0; ai < 2; ++ai)
#pragma unroll
                for (int m = 0; m < 4; ++m) {
                    const int en = tab[u.ui * 256 + ai * 128 + wr * 64 + m * 16 + fr];
                    float a[8];
#pragma unroll
                    for (int j = 0; j < 4; ++j) {
                        const float gv0 = fminf(__builtin_fmaf(acc[ai][0][m][0][j], W8_INV, bg0[j]), 7.f), uv0 = fminf(fmaxf(__builtin_fmaf(acc[ai][1][m][0][j], W8_INV, bu0[j]), -7.f), 7.f);
                        const float t0 = gv0 * __builtin_amdgcn_rcpf(1.f + __builtin_amdgcn_exp2f(gv0 * (-1.702f * 1.4426950408889634f))); a[j] = __builtin_fmaf(uv0, t0, t0);
                        const float gv1 = fminf(__builtin_fmaf(acc[ai][0][m][1][j], W8_INV, bg1[j]), 7.f), uv1 = fminf(fmaxf(__builtin_fmaf(acc[ai][1][m][1][j], W8_INV, bu1[j]), -7.f), 7.f);
                        const float t1 = gv1 * __builtin_amdgcn_rcpf(1.f + __builtin_amdgcn_exp2f(gv1 * (-1.702f * 1.4426950408889634f))); a[4 + j] = __builtin_fmaf(uv1, t1, t1);
                    }
                    if (en >= 0) { uint2 w; w.x = pk4_fp8(a[0], a[1], a[2], a[3]); w.y = pk4_fp8(a[4], a[5], a[6], a[7]); *(uint2*)(O + (size_t)en * DFF_ + c0) = w; }
                }
        } else {
            const int c0 = u.pn * 256 + wc * 32 + 8 * fq;
            f32x4 bv[2][2];
#pragma unroll
            for (int bj = 0; bj < 2; ++bj) { const u32x4 bw = *(const LAS u32x4*)(biasl + u.ui * 256 + 128 * bj + wc * 32 + 8 * fq);
                bv[bj][0] = (f32x4){__uint_as_float(bw.x << 16), __uint_as_float(bw.x & 0xffff0000u), __uint_as_float(bw.y << 16), __uint_as_float(bw.y & 0xffff0000u)};
                bv[bj][1] = (f32x4){__uint_as_float(bw.z << 16), __uint_as_float(bw.z & 0xffff0000u), __uint_as_float(bw.w << 16), __uint_as_float(bw.w & 0xffff0000u)}; }
#pragma unroll
            for (int ai = 0; ai < 2; ++ai)
#pragma unroll
                for (int m = 0; m < 4; ++m) {
                    const int en = tab[u.ui * 256 + ai * 128 + wr * 64 + m * 16 + fr];
                    if (en >= 0) {
                        constexpr float KS = OUT2_SCALE * W8_INV;
#pragma unroll
                        for (int bj = 0; bj < 2; ++bj) { f32x4 v0, v1;
#pragma unroll
                            for (int j = 0; j < 4; ++j) { v0[j] = __builtin_fmaf(acc[ai][bj][m][0][j], KS, bv[bj][0][j]); v1[j] = __builtin_fmaf(acc[ai][bj][m][1][j], KS, bv[bj][1][j]); }
#define CL8(x) fminf(fmaxf((x), -448.f), 448.f)
                            uint2 w; w.x = pk4_fp8(CL8(v0[0]), CL8(v0[1]), CL8(v0[2]), CL8(v0[3])); w.y = pk4_fp8(CL8(v1[0]), CL8(v1[1]), CL8(v1[2]), CL8(v1[3]));
#undef CL8
                            *(uint2*)(O + (size_t)en * D_ + c0 + 128 * bj) = w; }
                    }
                }
        }
    }
};

template <int GEMM>
__device__ __forceinline__ void phase_moe_fast8(const Params& p, int bid, int nb, LAS unsigned char* lds) {
    const unsigned* ecnt = (const unsigned*)(p.ws + OFF_CTL) + CW_ECNT;
    LAS int* pre = (LAS int*)(lds + pg8::STAGE_BYTES);
    LAS int* tab = (LAS int*)(lds + MOE_TAB_OFF);
    __syncthreads();
    if (tidx() == 0) { int a = 0; for (int e = 0; e < NE_; ++e) { pre[e] = a; a += ((int)ecnt[e] + 255) / 256; } pre[NE_] = a; }
    __syncthreads();
    ProbMoE8<GEMM> P{(const char*)(p.ws + (GEMM == 1 ? OFF_H : OFF_ACT)), (const char*)(p.ws + (GEMM == 1 ? OFF_WGU : OFF_WDN)), (unsigned char*)(p.ws + (GEMM == 1 ? OFF_ACT : OFF_OUT2)),
                     GEMM == 1 ? p.b_gu : p.b_dn, (const float*)(p.ws + OFF_GATE), ecnt, (const int*)(p.ws + OFF_ELIST), pre, tab, (LAS int*)(lds + pg8::STAGE_BYTES + 160), (LAS bf16_t*)(lds + MOE_BIAS_OFF), nb, bid};
    P.fill_tab();
    __syncthreads();
    pg8::gemm_phase8(lds, P);
}

__device__ __forceinline__ void phase2_fast(const Params& p, int bid, int nb, LAS unsigned char* lds) {
    if (INPROJ_FP8) {
        LAS float* lbl = (LAS float*)(lds + MOE_BIAS_OFF);
        __syncthreads();
        for (int i = tidx(); i < HW_; i += NTHREADS) lbl[i] = ((const float*)(p.ws + OFF_LB))[i];
        __syncthreads();
        ProbInProjT<true> P8{(const char*)(p.ws + OFF_H8), (const char*)(p.ws + OFF_WIN8), (bf16_t*)(p.ws + OFF_PROJ), (const float*)(p.ws + OFF_CS), (const float*)(p.ws + OFF_LB), nb, bid, lbl};
        pg8::gemm_phase8(lds, P8);
        ProbInProjT<false> P{(const char*)(p.ws + OFF_H), (const char*)(p.ws + OFF_WIN), (bf16_t*)(p.ws + OFF_PROJ), (const float*)(p.ws + OFF_CS), (const float*)(p.ws + OFF_LB), nb, bid, lbl};
        pg8::gemm_phase(lds, P);
    } else {
        ProbInProjFull P{{(const char*)(p.ws + OFF_H), (const char*)(p.ws + OFF_WIN), (bf16_t*)(p.ws + OFF_PROJ), (const float*)(p.ws + OFF_CS), (const float*)(p.ws + OFF_LB), nb, bid, nullptr}};
        pg8::gemm_phase(lds, P);
    }
}
__device__ __forceinline__ void phase5_fast(const Params& p, int bid, int nb, LAS unsigned char* lds) {
    ProbOutProj P{(const char*)(p.ws + OFF_MIX), (const char*)(p.ws + OFF_WOUT), p.x, (bf16_t*)(p.ws + OFF_X1B), (const float*)(p.ws + OFF_MOD), nb, bid};
    pg8::gemm_phase(lds, P);
}
template <int GEMM>
__device__ __forceinline__ void phase_moe_fast(const Params& p, int bid, int nb, LAS unsigned char* lds) {
    const unsigned* ecnt = (const unsigned*)(p.ws + OFF_CTL) + CW_ECNT;
    LAS int* pre = (LAS int*)(lds + pg8::STAGE_BYTES);
    LAS int* tab = (LAS int*)(lds + MOE_TAB_OFF);
    __syncthreads();
    if (tidx() == 0) { int a = 0; for (int e = 0; e < NE_; ++e) { pre[e] = a; a += ((int)ecnt[e] + 255) / 256; } pre[NE_] = a; }
    __syncthreads();
    ProbMoE<GEMM> P{(const char*)(p.ws + (GEMM == 1 ? OFF_H : OFF_ACT)), (const char*)(p.ws + (GEMM == 1 ? OFF_WGU : OFF_WDN)), (bf16_t*)(p.ws + (GEMM == 1 ? OFF_ACT : OFF_OUT2)),
                    GEMM == 1 ? p.b_gu : p.b_dn, (const float*)(p.ws + OFF_GATE), ecnt, (const int*)(p.ws + OFF_ELIST), pre, tab, nb, bid};
    P.fill_tab();
    __syncthreads();
    pg8::gemm_phase(lds, P);
}

__device__ __forceinline__ void phase2(const Params& p, int bid, int nb) {
    const int lane = tidx() & 63, wave = tidx() >> 6, lr = lane & 15, g = lane >> 4;
    const bf16_t* H = (const bf16_t*)(p.ws + OFF_H);
    const bf16_t* WT = (const bf16_t*)(p.ws + OFF_WIN);
    bf16_t* PROJ = (bf16_t*)(p.ws + OFF_PROJ);
    const float* cs = (const float*)(p.ws + OFF_CS);
    constexpr int NMT = T_ / 128, NNT = NPROJ / 64;
    for (int u = bid; u < NMT * NNT; u += nb) {
        const int mt = u / NNT, nt = u % NNT;
        const int row0 = mt * 128 + wave * 16, col0 = nt * 64;
        const bf16_t* arow = H + (size_t)(row0 + lr) * D_;
        const bf16_t* bcol[4];
#pragma unroll
        for (int n = 0; n < 4; ++n) bcol[n] = WT + (size_t)(col0 + 16 * n + lr) * D_;
        f32x4 acc[4];
        wave_gemm<4>(arow, bcol, D_, acc);
#pragma unroll
        for (int n = 0; n < 4; ++n) {
            const int c = col0 + 16 * n + lr;
#pragma unroll
            for (int j = 0; j < 4; ++j) {
                const int t = row0 + 4 * g + j;
                float v = acc[n][j], o;
                if (c < C_HF) o = siluf_(v) * 0.08838834764831845f;
                else if (c < C_HI) {
                    const int jj = c - C_HF;
                    const float lb = 1.f / (1.f + expf(p.lb_logits[HW_ + jj] - p.lb_logits[jj]));
                    const float f = lb + (1.f - lb) * sigmoidf_(v);
                    o = logf(f);
                } else if (c < C_HG) o = v;
                else if (c < C_AQ) o = siluf_(v);
                else if (c < C_AV) {
                    const float partner = __shfl_xor(v, 8);
                    if (n == 0) {
                        const int i = lr & 7;
                        const float cv = cs[t * 16 + i], sv = cs[t * 16 + 8 + i];
                        o = (lr < 8) ? (v * cv - partner * sv) : (v * cv + partner * sv);
                    } else o = v;
                } else o = v;
                PROJ[(size_t)t * NPROJ + c] = f2bf(o);
            }
        }
    }
}

__device__ __forceinline__ void phase3(const Params& p, int bid, int nb) {
    const int lane = tidx() & 63, wave = tidx() >> 6;
    const bf16_t* PROJ = (const bf16_t*)(p.ws + OFF_PROJ);
    float* OH = (float*)(p.ws + OFF_U);
    if (!HG_FAST) for (int w = bid * NWAVES + wave; w < NB_ * NHH * 128; w += nb * NWAVES) {
        const int v = w & 127, h = (w >> 7) % NHH, b = w / (NHH * 128);
        float S0 = 0.f, S1 = 0.f;
        const bf16_t* base = PROJ + (size_t)b * S_ * NPROJ + h * 128;
#pragma unroll 4
        for (int s = 0; s < S_; ++s) {
            const bf16_t* r = base + (size_t)s * NPROJ;
            const float q0 = bf2f(r[C_HQ + lane]), q1 = bf2f(r[C_HQ + 64 + lane]);
            const float f0 = __expf(bf2f(r[C_HF + lane])), f1 = __expf(bf2f(r[C_HF + 64 + lane]));
            const float vv = bf2f(r[C_HI + v]);
            S0 = f0 * S0 + (1.f - f0) * vv; S1 = f1 * S1 + (1.f - f1) * vv;
            const float o = wave_sum(S0 * q0 + S1 * q1);
            if (lane == 0) OH[(size_t)(b * S_ + s) * HW_ + h * 128 + v] = o;
        }
    }
    float* KM = (float*)(p.ws + OFF_KM);
    if (!MB_FAST) for (int i = bid * NTHREADS + tidx(); i < NB_ * AHN * 64 * 64; i += nb * NTHREADS) {
        const int d = i & 63, j = (i >> 6) & 63, h = (i >> 12) & 3, b = i >> 14;
        const bf16_t* kp = PROJ + (size_t)(b * S_ + j * 256) * NPROJ + C_AK + h * 64 + d;
        float s = 0.f;
        for (int k = 0; k < 256; ++k) s += bf2f(kp[(size_t)k * NPROJ]);
        KM[i] = s * (1.f / 256.f);
    }
}

__device__ __forceinline__ void phase4(const Params& p, int bid, int nb) {
    const int lane = tidx() & 63, wave = tidx() >> 6;
    const bf16_t* PROJ = (const bf16_t*)(p.ws + OFF_PROJ);
    const float* OH = (const float*)(p.ws + OFF_U);
    bf16_t* MIX = (bf16_t*)(p.ws + OFF_MIX);
    if (!HG_FAST) for (int w = bid * NWAVES + wave; w < T_ * NHH; w += nb * NWAVES) {
        const int t = w / NHH, h = w % NHH;
        const float o0 = OH[(size_t)t * HW_ + h * 128 + lane], o1 = OH[(size_t)t * HW_ + h * 128 + 64 + lane];
        const float rstd = rsqrtf(wave_sum(o0 * o0 + o1 * o1) * (1.f / 128.f) + RMS_EPS);
        const float g0 = bf2f(PROJ[(size_t)t * NPROJ + C_HG + h * 128 + lane]), g1 = bf2f(PROJ[(size_t)t * NPROJ + C_HG + h * 128 + 64 + lane]);
        MIX[(size_t)t * D_ + h * 128 + lane] = f2bf(o0 * rstd * p.hgrn_norm_g[lane] * g0);
        MIX[(size_t)t * D_ + h * 128 + 64 + lane] = f2bf(o1 * rstd * p.hgrn_norm_g[64 + lane] * g1);
    }
    const float* KM = (const float*)(p.ws + OFF_KM);
    if (!MB_FAST) for (int idx = bid * NTHREADS + tidx(); idx < NB_ * AHN * S_; idx += nb * NTHREADS) {
        const int q = idx & (S_ - 1), h = (idx >> 14) & 3, b = idx >> 16;
        const int t = b * S_ + q, own = q >> 8;
        float qv[64];
        {
            const u32x4* qp = (const u32x4*)(PROJ + (size_t)t * NPROJ + C_AQ + h * 64);
#pragma unroll
            for (int c = 0; c < 8; ++c) { const u32x4 w = qp[c];
                qv[8 * c + 0] = __uint_as_float(w.x << 16); qv[8 * c + 1] = __uint_as_float(w.x & 0xffff0000u);
                qv[8 * c + 2] = __uint_as_float(w.y << 16); qv[8 * c + 3] = __uint_as_float(w.y & 0xffff0000u);
                qv[8 * c + 4] = __uint_as_float(w.z << 16); qv[8 * c + 5] = __uint_as_float(w.z & 0xffff0000u);
                qv[8 * c + 6] = __uint_as_float(w.w << 16); qv[8 * c + 7] = __uint_as_float(w.w & 0xffff0000u); }
        }
        float v0 = -INFINITY, v1 = -INFINITY, v2 = -INFINITY; int i0 = 0, i1 = 0, i2 = 0;
        for (int j = 0; j < own; ++j) {
            const float* km = KM + ((size_t)(b * AHN + h) * 64 + j) * 64;
            float gt = 0.f;
#pragma unroll
            for (int d = 0; d < 64; ++d) gt += qv[d] * km[d];
            if (gt > v0) { v2 = v1; i2 = i1; v1 = v0; i1 = i0; v0 = gt; i0 = j; }
            else if (gt > v1) { v2 = v1; i2 = i1; v1 = gt; i1 = j; }
            else if (gt > v2) { v2 = gt; i2 = j; }
        }
        const int nsel = own < 3 ? own : 3;
        float m = -INFINITY, l = 0.f, ov[64];
#pragma unroll
        for (int d = 0; d < 64; ++d) ov[d] = 0.f;
        for (int sidx = 0; sidx <= nsel; ++sidx) {
            const int blk = (sidx == nsel) ? own : (sidx == 0 ? i0 : (sidx == 1 ? i1 : i2));
            const int nk = (sidx == nsel) ? ((q & 255) + 1) : 256;
            const bf16_t* kb = PROJ + (size_t)(b * S_ + blk * 256) * NPROJ + C_AK + h * 64;
            for (int k = 0; k < nk; ++k) {
                const u32x4* kp = (const u32x4*)(kb + (size_t)k * NPROJ);
                float s = 0.f;
#pragma unroll
                for (int c = 0; c < 8; ++c) { const u32x4 w = kp[c];
                    s += qv[8 * c + 0] * __uint_as_float(w.x << 16) + qv[8 * c + 1] * __uint_as_float(w.x & 0xffff0000u)
                       + qv[8 * c + 2] * __uint_as_float(w.y << 16) + qv[8 * c + 3] * __uint_as_float(w.y & 0xffff0000u)
                       + qv[8 * c + 4] * __uint_as_float(w.z << 16) + qv[8 * c + 5] * __uint_as_float(w.z & 0xffff0000u)
                       + qv[8 * c + 6] * __uint_as_float(w.w << 16) + qv[8 * c + 7] * __uint_as_float(w.w & 0xffff0000u); }
                s *= 0.125f;
                if (s > m) { const float corr = __expf(m - s); l *= corr;
#pragma unroll
                    for (int d = 0; d < 64; ++d) ov[d] *= corr;
                    m = s; }
                const float pr = __expf(s - m); l += pr;
                const u32x4* vp = (const u32x4*)(kb + (size_t)k * NPROJ + (C_AV - C_AK));
#pragma unroll
                for (int c = 0; c < 8; ++c) { const u32x4 w = vp[c];
                    ov[8 * c + 0] += pr * __uint_as_float(w.x << 16); ov[8 * c + 1] += pr * __uint_as_float(w.x & 0xffff0000u);
                    ov[8 * c + 2] += pr * __uint_as_float(w.y << 16); ov[8 * c + 3] += pr * __uint_as_float(w.y & 0xffff0000u);
                    ov[8 * c + 4] += pr * __uint_as_float(w.z << 16); ov[8 * c + 5] += pr * __uint_as_float(w.z & 0xffff0000u);
                    ov[8 * c + 6] += pr * __uint_as_float(w.w << 16); ov[8 * c + 7] += pr * __uint_as_float(w.w & 0xffff0000u); }
            }
        }
        const float inv = 1.f / l; float ss = 0.f;
#pragma unroll
        for (int d = 0; d < 64; ++d) { ov[d] *= inv; ss += ov[d] * ov[d]; }
        const float rstd = rsqrtf(ss * (1.f / 64.f) + RMS_EPS);
        u32x4* op = (u32x4*)(MIX + (size_t)t * D_ + HW_ + h * 64);
#pragma unroll
        for (int c = 0; c < 8; ++c) { u32x4 w;
            w.x = pk2(ov[8 * c + 0] * rstd * p.attn_norm_g[8 * c + 0], ov[8 * c + 1] * rstd * p.attn_norm_g[8 * c + 1]);
            w.y = pk2(ov[8 * c + 2] * rstd * p.attn_norm_g[8 * c + 2], ov[8 * c + 3] * rstd * p.attn_norm_g[8 * c + 3]);
            w.z = pk2(ov[8 * c + 4] * rstd * p.attn_norm_g[8 * c + 4], ov[8 * c + 5] * rstd * p.attn_norm_g[8 * c + 5]);
            w.w = pk2(ov[8 * c + 6] * rstd * p.attn_norm_g[8 * c + 6], ov[8 * c + 7] * rstd * p.attn_norm_g[8 * c + 7]);
            op[c] = w; }
    }
}


typedef short s16x4 __attribute__((ext_vector_type(4)));
constexpr size_t OFF_UT = OFF_U;
constexpr size_t OFF_MLIST = OFF_X;
constexpr size_t OFF_LP = OFF_X + 17 * MBy;
constexpr size_t OFF_MP = OFF_LP + 2 * MBy;
constexpr int MLIST_STRIDE = 516096;

__device__ __forceinline__ void hgrn_cumsum(const bf16_t* lfcol, int sq, int k, LAS float* qs, float (&lf)[16], float (&bb)[16], float (&rq)[5]) {
    float run = 0.f;
#pragma unroll
    for (int i = 0; i < 16; ++i) { lf[i] = bf2f(lfcol[(size_t)(16 * sq + i) * NPROJ]); run += lf[i]; bb[i] = run; }
    qs[sq * 128 + k] = run;
    __syncthreads();
    const float q0 = qs[k], q1 = qs[128 + k], q2 = qs[256 + k], q3 = qs[384 + k];
    rq[0] = 0.f; rq[1] = q0; rq[2] = q0 + q1; rq[3] = q0 + q1 + q2; rq[4] = q0 + q1 + q2 + q3;
    const float off = sq == 0 ? 0.f : (sq == 1 ? rq[1] : (sq == 2 ? rq[2] : rq[3]));
#pragma unroll
    for (int i = 0; i < 16; ++i) bb[i] += off;
}
__device__ __forceinline__ void st16_bf16(LAS bf16_t* dst, const float (&v)[16]) {
    u32x4 a, b;
    a.x = pk2(v[0], v[1]); a.y = pk2(v[2], v[3]); a.z = pk2(v[4], v[5]); a.w = pk2(v[6], v[7]);
    b.x = pk2(v[8], v[9]); b.y = pk2(v[10], v[11]); b.z = pk2(v[12], v[13]); b.w = pk2(v[14], v[15]);
    *(LAS u32x4*)dst = a; *(LAS u32x4*)(dst + 8) = b;
}

__device__ __forceinline__ void hgrn_local_unit(const Params& p, int unit, LAS unsigned char* lds) {
    const int tid = tidx(), k = tid & 127, sq = tid >> 7, lane = tid & 63, w = tid >> 6, fr = lane & 15, g = lane >> 4;
    const int c = unit & 255, bh = unit >> 8, h = bh % NHH, b = bh / NHH;
    const bf16_t* PROJ = (const bf16_t*)(p.ws + OFF_PROJ);
    const bf16_t* rowb = PROJ + (size_t)(b * S_ + c * 64) * NPROJ + h * 128 + k;
    LAS float* qs = (LAS float*)lds;
    LAS bf16_t* KT = (LAS bf16_t*)(lds + 2048);
    LAS bf16_t* VT = KT + 128 * 72;
    float lf[16], bb[16], rq[5];
    hgrn_cumsum(rowb + C_HF, sq, k, qs, lf, bb, rq);
    const float bl = rq[4];
    float tmp[16];
#pragma unroll
    for (int i = 0; i < 16; ++i) tmp[i] = (1.f - __expf(lf[i])) * __expf(bl - bb[i]);
    st16_bf16(KT + k * 72 + 16 * sq, tmp);
#pragma unroll
    for (int i = 0; i < 16; ++i) tmp[i] = bf2f(rowb[(size_t)(16 * sq + i) * NPROJ + C_HI]);
    st16_bf16(VT + k * 72 + 16 * sq, tmp);
    if (sq == 0) ((float*)(p.ws + OFF_DEC))[unit * 128 + k] = __expf(bl);
    __syncthreads();
    const bf16x8 a0 = *(const LAS bf16x8*)(KT + (16 * w + fr) * 72 + 8 * g), a1 = *(const LAS bf16x8*)(KT + (16 * w + fr) * 72 + 32 + 8 * g);
    bf16_t* UT = (bf16_t*)(p.ws + OFF_UT) + (size_t)unit * 16384;
#pragma unroll
    for (int n = 0; n < 8; ++n) {
        const bf16x8 b0 = *(const LAS bf16x8*)(VT + (16 * n + fr) * 72 + 8 * g), b1 = *(const LAS bf16x8*)(VT + (16 * n + fr) * 72 + 32 + 8 * g);
        f32x4 acc = (f32x4){0.f, 0.f, 0.f, 0.f};
        acc = __builtin_amdgcn_mfma_f32_16x16x32_bf16(a0, b0, acc, 0, 0, 0);
        acc = __builtin_amdgcn_mfma_f32_16x16x32_bf16(a1, b1, acc, 0, 0, 0);
        uint2 o; o.x = pk2(acc[0], acc[1]); o.y = pk2(acc[2], acc[3]);
        *(uint2*)(UT + (16 * n + fr) * 128 + 16 * w + 4 * g) = o;
    }
    __syncthreads();
}

__device__ __forceinline__ void hgrn_scan(const Params& p, int bid, int nb, bool dummy = false) {
    bf16_t* UT = (bf16_t*)(p.ws + (dummy ? OFF_OP : OFF_UT));
    const float* DEC = (const float*)(p.ws + OFF_DEC);
    const int per_blk = (NB_ * NHH * 8192 + nb - 1) / nb;
    for (int idx = bid * per_blk + tidx(); idx < NB_ * NHH * 8192 && idx < (bid + 1) * per_blk; idx += NTHREADS) {
        const int bh = idx >> 13, r = idx & 8191;
        bf16_t* base = UT + (size_t)bh * 256 * 16384 + r * 2;
        const float* db = DEC + (size_t)bh * 256 * 128 + (r & 63) * 2;
        float s0 = 0.f, s1 = 0.f;
        for (int c0 = 0; c0 < 256; c0 += 16) {
            unsigned u[16]; float2 d[16];
#pragma unroll
            for (int i = 0; i < 16; ++i) { u[i] = *(const unsigned*)(base + (size_t)(c0 + i) * 16384); d[i] = *(const float2*)(db + (c0 + i) * 128); }
#pragma unroll
            for (int i = 0; i < 16; ++i) {
                *(unsigned*)(base + (size_t)(c0 + i) * 16384) = pk2(s0, s1);
                s0 = d[i].x * s0 + __uint_as_float(u[i] << 16); s1 = d[i].y * s1 + __uint_as_float(u[i] & 0xffff0000u);
            }
        }
    }
}

__device__ __forceinline__ void hgrn_out_unit(const Params& p, int unit, LAS unsigned char* lds) {
    const int tid = tidx(), k = tid & 127, sq = tid >> 7, lane = tid & 63, w = tid >> 6, fr = lane & 15, g = lane >> 4;
    const int c = unit & 255, bh = unit >> 8, h = bh % NHH, b = bh / NHH;
    const bf16_t* PROJ = (const bf16_t*)(p.ws + OFF_PROJ);
    const size_t t0 = (size_t)b * S_ + c * 64;
    const bf16_t* rowb = PROJ + t0 * NPROJ + h * 128 + k;
    LAS float* qs = (LAS float*)lds;
    LAS float* ssum = (LAS float*)(lds + 2048);
    LAS bf16_t* Q0 = (LAS bf16_t*)(lds + 4096);
    LAS bf16_t* KS = Q0 + 64 * 136;
    LAS bf16_t* QV = KS + 64 * 136;
    LAS bf16_t* VT = QV + 10 * 16 * 136;
    LAS bf16_t* PL = VT + 128 * 72;
    const bf16_t* ST = (const bf16_t*)(p.ws + OFF_UT) + (size_t)unit * 16384 + (size_t)(16 * w + fr) * 128 + 8 * g;
    bf16x8 aS[4];
#pragma unroll
    for (int ks = 0; ks < 4; ++ks) aS[ks] = *(const bf16x8*)(ST + 32 * ks);
    float lf[16], bb[16], rq[5];
    hgrn_cumsum(rowb + C_HF, sq, k, qs, lf, bb, rq);
    {
        float qq[16];
#pragma unroll
        for (int i = 0; i < 16; ++i) qq[i] = bf2f(rowb[(size_t)(16 * sq + i) * NPROJ + C_HQ]);
        const float rI = sq == 0 ? rq[1] : (sq == 1 ? rq[2] : (sq == 2 ? rq[3] : rq[4]));
#pragma unroll
        for (int i = 0; i < 16; ++i) {
            Q0[(16 * sq + i) * 136 + k] = f2bf(qq[i] * __expf(bb[i]));
            KS[(16 * sq + i) * 136 + k] = f2bf((1.f - __expf(lf[i])) * __expf(rI - bb[i]));
        }
#pragma unroll
        for (int J = 0; J < 4; ++J) {
            if (J <= sq) {
                const int pair = (sq * (sq + 1)) / 2 + J;
#pragma unroll
                for (int i = 0; i < 16; ++i) QV[(pair * 16 + i) * 136 + k] = f2bf(qq[i] * __expf(bb[i] - rq[J + 1]));
            }
        }
        float tmp[16];
#pragma unroll
        for (int i = 0; i < 16; ++i) tmp[i] = bf2f(rowb[(size_t)(16 * sq + i) * NPROJ + C_HI]);
        st16_bf16(VT + k * 72 + 16 * sq, tmp);
    }
    __syncthreads();
#pragma unroll
    for (int rep = 0; rep < 2; ++rep) {
        const int id = w + 8 * rep, I = id >> 2, J = id & 3;
        f32x4 acc = (f32x4){0.f, 0.f, 0.f, 0.f};
        if (J <= I) {
            const int pair = (I * (I + 1)) / 2 + J;
#pragma unroll
            for (int ks = 0; ks < 4; ++ks) {
                const bf16x8 a = *(const LAS bf16x8*)(QV + (pair * 16 + fr) * 136 + 32 * ks + 8 * g);
                const bf16x8 bq = *(const LAS bf16x8*)(KS + (16 * J + fr) * 136 + 32 * ks + 8 * g);
                acc = __builtin_amdgcn_mfma_f32_16x16x32_bf16(a, bq, acc, 0, 0, 0);
            }
            if (I == J) {
#pragma unroll
                for (int j = 0; j < 4; ++j) if (fr > 4 * g + j) acc[j] = 0.f;
            }
        }
#pragma unroll
        for (int j = 0; j < 4; ++j) PL[(16 * I + 4 * g + j) * 72 + 16 * J + fr] = f2bf(acc[j]);
    }
    __syncthreads();
    const bf16x8 aV0 = *(const LAS bf16x8*)(VT + (16 * w + fr) * 72 + 8 * g), aV1 = *(const LAS bf16x8*)(VT + (16 * w + fr) * 72 + 32 + 8 * g);
    f32x4 o[4];
#pragma unroll
    for (int ti = 0; ti < 4; ++ti) {
        f32x4 acc = (f32x4){0.f, 0.f, 0.f, 0.f};
#pragma unroll
        for (int ks = 0; ks < 4; ++ks) { const bf16x8 bq = *(const LAS bf16x8*)(Q0 + (16 * ti + fr) * 136 + 32 * ks + 8 * g); acc = __builtin_amdgcn_mfma_f32_16x16x32_bf16(aS[ks], bq, acc, 0, 0, 0); }
        { const bf16x8 b0 = *(const LAS bf16x8*)(PL + (16 * ti + fr) * 72 + 8 * g), b1 = *(const LAS bf16x8*)(PL + (16 * ti + fr) * 72 + 32 + 8 * g);
          acc = __builtin_amdgcn_mfma_f32_16x16x32_bf16(aV0, b0, acc, 0, 0, 0); acc = __builtin_amdgcn_mfma_f32_16x16x32_bf16(aV1, b1, acc, 0, 0, 0); }
        o[ti] = acc;
        float ss = acc[0] * acc[0] + acc[1] * acc[1] + acc[2] * acc[2] + acc[3] * acc[3];
        ss += __shfl_xor(ss, 16); ss += __shfl_xor(ss, 32);
        if (g == 0) ssum[w * 64 + 16 * ti + fr] = ss;
    }
    __syncthreads();
    bf16_t* MIX = (bf16_t*)(p.ws + OFF_MIX);
    const f32x4 ng = *(const f32x4*)(p.hgrn_norm_g + 16 * w + 4 * g);
#pragma unroll
    for (int ti = 0; ti < 4; ++ti) {
        float tot = 0.f;
#pragma unroll
        for (int ww = 0; ww < 8; ++ww) tot += ssum[ww * 64 + 16 * ti + fr];
        const float rstd = rsqrtf(tot * (1.f / 128.f) + RMS_EPS);
        const size_t t = t0 + 16 * ti + fr;
        const uint2 gw = *(const uint2*)(PROJ + t * NPROJ + C_HG + h * 128 + 16 * w + 4 * g);
        uint2 ow;
        ow.x = pk2(o[ti][0] * rstd * ng[0] * __uint_as_float(gw.x << 16), o[ti][1] * rstd * ng[1] * __uint_as_float(gw.x & 0xffff0000u));
        ow.y = pk2(o[ti][2] * rstd * ng[2] * __uint_as_float(gw.y << 16), o[ti][3] * rstd * ng[3] * __uint_as_float(gw.y & 0xffff0000u));
        *(uint2*)(MIX + t * D_ + h * 128 + 16 * w + 4 * g) = ow;
    }
    __syncthreads();
}


#define TRRD(dst, addr, off) asm volatile("ds_read_b64_tr_b16 %0, %1 offset:%2" : "=&v"(dst) : "v"(addr), "i"(off) : "memory")
#define LGKM0() do { asm volatile("s_waitcnt lgkmcnt(0)" ::: "memory"); __builtin_amdgcn_sched_barrier(0); } while (0)
constexpr int HT_STRIDE = 136;
template <int NT_> struct HgRegs { u32x4 v[NT_][2]; };
template <int NT_>
__device__ __forceinline__ void hgrn_stage_load(const bf16_t* PROJ, size_t t0, const int (&col)[NT_], HgRegs<NT_>& rg) {
    const int tid = tidx();
#pragma unroll
    for (int i = 0; i < NT_; ++i)
#pragma unroll
        for (int r = 0; r < 2; ++r) { const int id = tid + NTHREADS * r, row = id >> 4, ch = id & 15; rg.v[i][r] = *(const u32x4*)(PROJ + (t0 + row) * NPROJ + col[i] + 8 * ch); }
}
template <int NT_>
__device__ __forceinline__ void hgrn_stage_store(LAS bf16_t* const (&tile)[NT_], const HgRegs<NT_>& rg) {
    const int tid = tidx();
#pragma unroll
    for (int i = 0; i < NT_; ++i)
#pragma unroll
        for (int r = 0; r < 2; ++r) { const int id = tid + NTHREADS * r, row = id >> 4, ch = id & 15; *(LAS u32x4*)(tile[i] + row * HT_STRIDE + 8 * ch) = rg.v[i][r]; }
}
__device__ __forceinline__ size_t hgrn_unit_t0(int unit, int& h) { const int c = unit & 255, bh = unit >> 8; h = bh % NHH; return (size_t)(bh / NHH) * S_ + c * 64; }
__device__ __forceinline__ void hgrn_cumsum_mfma(LAS bf16_t* LF, int w, int fr, int g, f32x4 (&bT)[4]) {
    const unsigned base = (unsigned)(size_t)LF + (unsigned)((4 * g + (fr >> 2)) * (HT_STRIDE * 2) + (16 * w + 4 * (fr & 3)) * 2);
    s16x4 lo0, hi0, lo1, hi1;
    TRRD(lo0, base, 0); TRRD(hi0, base, 16 * HT_STRIDE * 2); TRRD(lo1, base, 32 * HT_STRIDE * 2); TRRD(hi1, base, 48 * HT_STRIDE * 2);
    LGKM0();
    const bf16x8 a0 = (bf16x8){lo0[0], lo0[1], lo0[2], lo0[3], hi0[0], hi0[1], hi0[2], hi0[3]};
    const bf16x8 a1 = (bf16x8){lo1[0], lo1[1], lo1[2], lo1[3], hi1[0], hi1[1], hi1[2], hi1[3]};
#pragma unroll
    for (int ti = 0; ti < 4; ++ti) {
        const int t = 16 * ti + fr;
        bf16x8 b0, b1;
#pragma unroll
        for (int e = 0; e < 4; ++e) {
            b0[e] = (4 * g + e <= t) ? (short)0x3F80 : (short)0;          b0[4 + e] = (16 + 4 * g + e <= t) ? (short)0x3F80 : (short)0;
            b1[e] = (32 + 4 * g + e <= t) ? (short)0x3F80 : (short)0;     b1[4 + e] = (48 + 4 * g + e <= t) ? (short)0x3F80 : (short)0;
        }
        f32x4 acc = (f32x4){0.f, 0.f, 0.f, 0.f};
        acc = __builtin_amdgcn_mfma_f32_16x16x32_bf16(a0, b0, acc, 0, 0, 0);
        acc = __builtin_amdgcn_mfma_f32_16x16x32_bf16(a1, b1, acc, 0, 0, 0);
        bT[ti] = acc;
    }
}
__device__ __forceinline__ f32x4 ld4bf(const LAS bf16_t* p) { const u32x2 v = *(const LAS u32x2*)p; return (f32x4){__uint_as_float(v.x << 16), __uint_as_float(v.x & 0xffff0000u), __uint_as_float(v.y << 16), __uint_as_float(v.y & 0xffff0000u)}; }
__device__ __forceinline__ void st4bf(LAS bf16_t* p, float a, float b, float c, float d) { u32x2 v; v.x = pk2(a, b); v.y = pk2(c, d); *(LAS u32x2*)p = v; }

__device__ __forceinline__ void hgrn_local_load(const Params& p, int unit, HgRegs<2>& rg) {
    int h; const size_t t0 = hgrn_unit_t0(unit, h);
    const int col[2] = {C_HF + h * 128, C_HI + h * 128};
    hgrn_stage_load<2>((const bf16_t*)(p.ws + OFF_PROJ), t0, col, rg);
}
__device__ __forceinline__ void hgrn_local_unit2(const Params& p, int unit, int next_unit, HgRegs<2>& rg, LAS unsigned char* lds) {
    const int tid = tidx(), lane = tid & 63, w = tid >> 6, fr = lane & 15, g = lane >> 4;
    LAS bf16_t* LF = (LAS bf16_t*)lds;
    LAS bf16_t* VV = LF + 64 * HT_STRIDE;
    __syncthreads();
    { LAS bf16_t* const tl[2] = {LF, VV}; hgrn_stage_store<2>(tl, rg); }
    if (next_unit >= 0) hgrn_local_load(p, next_unit, rg);
    __syncthreads();
    f32x4 bT[4];
    hgrn_cumsum_mfma(LF, w, fr, g, bT);
    f32x4 bl;
#pragma unroll
    for (int j = 0; j < 4; ++j) bl[j] = __shfl(bT[3][j], (lane & 48) | 15);
#pragma unroll
    for (int ti = 0; ti < 4; ++ti) {
        LAS bf16_t* pp = LF + (16 * ti + fr) * HT_STRIDE + 16 * w + 4 * g;
        const f32x4 lf = ld4bf(pp);
        st4bf(pp, (1.f - __expf(lf[0])) * __expf(bl[0] - bT[ti][0]), (1.f - __expf(lf[1])) * __expf(bl[1] - bT[ti][1]),
                  (1.f - __expf(lf[2])) * __expf(bl[2] - bT[ti][2]), (1.f - __expf(lf[3])) * __expf(bl[3] - bT[ti][3]));
    }
    if (fr == 0) *(f32x4*)((float*)(p.ws + OFF_DEC) + unit * 128 + 16 * w + 4 * g) = (f32x4){__expf(bl[0]), __expf(bl[1]), __expf(bl[2]), __expf(bl[3])};
    const unsigned rowoff = (unsigned)((4 * g + (fr >> 2)) * (HT_STRIDE * 2) + 4 * (fr & 3) * 2);
    const unsigned abase = (unsigned)(size_t)LF + rowoff + (unsigned)(16 * w * 2);
    s16x4 lo0, hi0, lo1, hi1;
    TRRD(lo0, abase, 0); TRRD(hi0, abase, 16 * HT_STRIDE * 2); TRRD(lo1, abase, 32 * HT_STRIDE * 2); TRRD(hi1, abase, 48 * HT_STRIDE * 2);
    LGKM0();
    const bf16x8 a0 = (bf16x8){lo0[0], lo0[1], lo0[2], lo0[3], hi0[0], hi0[1], hi0[2], hi0[3]};
    const bf16x8 a1 = (bf16x8){lo1[0], lo1[1], lo1[2], lo1[3], hi1[0], hi1[1], hi1[2], hi1[3]};
    bf16_t* UT = (bf16_t*)(p.ws + OFF_UT) + (size_t)unit * 16384;
    const unsigned vbase = (unsigned)(size_t)VV + rowoff;
#pragma unroll
    for (int n = 0; n < 8; ++n) {
        s16x4 l0, h0, l1, h1;
        TRRD(l0, vbase, n * 32); TRRD(h0, vbase, n * 32 + 16 * HT_STRIDE * 2); TRRD(l1, vbase, n * 32 + 32 * HT_STRIDE * 2); TRRD(h1, vbase, n * 32 + 48 * HT_STRIDE * 2);
        LGKM0();
        const bf16x8 b0 = (bf16x8){l0[0], l0[1], l0[2], l0[3], h0[0], h0[1], h0[2], h0[3]};
        const bf16x8 b1 = (bf16x8){l1[0], l1[1], l1[2], l1[3], h1[0], h1[1], h1[2], h1[3]};
        f32x4 acc = (f32x4){0.f, 0.f, 0.f, 0.f};
        acc = __builtin_amdgcn_mfma_f32_16x16x32_bf16(a0, b0, acc, 0, 0, 0);
        acc = __builtin_amdgcn_mfma_f32_16x16x32_bf16(a1, b1, acc, 0, 0, 0);
        uint2 o; o.x = pk2(acc[0], acc[1]); o.y = pk2(acc[2], acc[3]);
        *(uint2*)(UT + (16 * n + fr) * 128 + 16 * w + 4 * g) = o;
    }
}

struct HgOutRegs { HgRegs<3> t; bf16x8 aS[4]; uint2 gw[4]; };
__device__ __forceinline__ void hgrn_out_load(const Params& p, int unit, HgOutRegs& rg) {
    const int lane = tidx() & 63, w = tidx() >> 6, fr = lane & 15, g = lane >> 4;
    int h; const size_t t0 = hgrn_unit_t0(unit, h);
    const bf16_t* ST = (const bf16_t*)(p.ws + OFF_UT) + (size_t)unit * 16384 + (size_t)(16 * w + fr) * 128 + 8 * g;
#pragma unroll
    for (int ks = 0; ks < 4; ++ks) rg.aS[ks] = *(const bf16x8*)(ST + 32 * ks);
    const int col[3] = {C_HF + h * 128, C_HQ + h * 128, C_HI + h * 128};
    hgrn_stage_load<3>((const bf16_t*)(p.ws + OFF_PROJ), t0, col, rg.t);
#pragma unroll
    for (int ti = 0; ti < 4; ++ti) rg.gw[ti] = *(const uint2*)((const bf16_t*)(p.ws + OFF_PROJ) + (t0 + 16 * ti + fr) * NPROJ + C_HG + h * 128 + 16 * w + 4 * g);
}
__device__ __forceinline__ void hgrn_out_unit2(const Params& p, int unit, int next_unit, HgOutRegs& rg, LAS unsigned char* lds) {
    const int tid = tidx(), lane = tid & 63, w = tid >> 6, fr = lane & 15, g = lane >> 4;
    int h; const size_t t0 = hgrn_unit_t0(unit, h);
    const bf16_t* PROJ = (const bf16_t*)(p.ws + OFF_PROJ);
    LAS float* ssum = (LAS float*)lds;
    LAS bf16_t* LF = (LAS bf16_t*)(lds + 2048);
    LAS bf16_t* QQ = LF + 64 * HT_STRIDE;
    LAS bf16_t* VV = QQ + 64 * HT_STRIDE;
    LAS bf16_t* QV = VV + 64 * HT_STRIDE;
    LAS bf16_t* PL = QV + 10 * 16 * HT_STRIDE;
    bf16x8 aS[4]; uint2 gwv[4];
#pragma unroll
    for (int ks = 0; ks < 4; ++ks) { aS[ks] = rg.aS[ks]; gwv[ks] = rg.gw[ks]; }
    __syncthreads();
    { LAS bf16_t* const tl[3] = {LF, QQ, VV}; hgrn_stage_store<3>(tl, rg.t); }
    if (next_unit >= 0) hgrn_out_load(p, next_unit, rg);
    __syncthreads();
    f32x4 bT[4];
    hgrn_cumsum_mfma(LF, w, fr, g, bT);
    f32x4 rJ[4];
#pragma unroll
    for (int J = 0; J < 4; ++J)
#pragma unroll
        for (int j = 0; j < 4; ++j) rJ[J][j] = __shfl(bT[J][j], (lane & 48) | 15);
#pragma unroll
    for (int ti = 0; ti < 4; ++ti) {
        const int co = (16 * ti + fr) * HT_STRIDE + 16 * w + 4 * g;
        const f32x4 lf = ld4bf(LF + co), qq = ld4bf(QQ + co);
        st4bf(QQ + co, qq[0] * __expf(bT[ti][0]), qq[1] * __expf(bT[ti][1]), qq[2] * __expf(bT[ti][2]), qq[3] * __expf(bT[ti][3]));
        st4bf(LF + co, (1.f - __expf(lf[0])) * __expf(rJ[ti][0] - bT[ti][0]), (1.f - __expf(lf[1])) * __expf(rJ[ti][1] - bT[ti][1]),
                       (1.f - __expf(lf[2])) * __expf(rJ[ti][2] - bT[ti][2]), (1.f - __expf(lf[3])) * __expf(rJ[ti][3] - bT[ti][3]));
#pragma unroll
        for (int J = 0; J < 4; ++J) {
            if (J <= ti) {
                const int pair = (ti * (ti + 1)) / 2 + J;
                st4bf(QV + (pair * 16 + fr) * HT_STRIDE + 16 * w + 4 * g, qq[0] * __expf(bT[ti][0] - rJ[J][0]), qq[1] * __expf(bT[ti][1] - rJ[J][1]),
                      qq[2] * __expf(bT[ti][2] - rJ[J][2]), qq[3] * __expf(bT[ti][3] - rJ[J][3]));
            }
        }
    }
    __syncthreads();
#pragma unroll
    for (int rep = 0; rep < 2; ++rep) {
        const int id = w + 8 * rep, I = id >> 2, J = id & 3;
        f32x4 acc = (f32x4){0.f, 0.f, 0.f, 0.f};
        if (J <= I) {
            const int pair = (I * (I + 1)) / 2 + J;
#pragma unroll
            for (int ks = 0; ks < 4; ++ks) {
                const bf16x8 a = *(const LAS bf16x8*)(QV + (pair * 16 + fr) * HT_STRIDE + 32 * ks + 8 * g);
                const bf16x8 bq = *(const LAS bf16x8*)(LF + (16 * J + fr) * HT_STRIDE + 32 * ks + 8 * g);
                acc = __builtin_amdgcn_mfma_f32_16x16x32_bf16(a, bq, acc, 0, 0, 0);
            }
            if (I == J) {
#pragma unroll
                for (int j = 0; j < 4; ++j) if (fr > 4 * g + j) acc[j] = 0.f;
            }
        }
#pragma unroll
        for (int j = 0; j < 4; ++j) PL[(16 * I + 4 * g + j) * 72 + 16 * J + fr] = f2bf(acc[j]);
    }
    __syncthreads();
    const unsigned vbase = (unsigned)(size_t)VV + (unsigned)((4 * g + (fr >> 2)) * (HT_STRIDE * 2) + (16 * w + 4 * (fr & 3)) * 2);
    s16x4 l0, h0, l1, h1;
    TRRD(l0, vbase, 0); TRRD(h0, vbase, 16 * HT_STRIDE * 2); TRRD(l1, vbase, 32 * HT_STRIDE * 2); TRRD(h1, vbase, 48 * HT_STRIDE * 2);
    LGKM0();
    const bf16x8 aV0 = (bf16x8){l0[0], l0[1], l0[2], l0[3], h0[0], h0[1], h0[2], h0[3]};
    const bf16x8 aV1 = (bf16x8){l1[0], l1[1], l1[2], l1[3], h1[0], h1[1], h1[2], h1[3]};
    f32x4 o[4];
#pragma unroll
    for (int ti = 0; ti < 4; ++ti) {
        f32x4 acc = (f32x4){0.f, 0.f, 0.f, 0.f};
#pragma unroll
        for (int ks = 0; ks < 4; ++ks) { const bf16x8 bq = *(const LAS bf16x8*)(QQ + (16 * ti + fr) * HT_STRIDE + 32 * ks + 8 * g); acc = __builtin_amdgcn_mfma_f32_16x16x32_bf16(aS[ks], bq, acc, 0, 0, 0); }
        {
            const LAS bf16_t* pr = PL + (16 * ti + fr) * 72 + 4 * g;
            const u32x2 x0 = *(const LAS u32x2*)(pr), x1 = *(const LAS u32x2*)(pr + 16), x2 = *(const LAS u32x2*)(pr + 32), x3 = *(const LAS u32x2*)(pr + 48);
            const bf16x8 b0 = __builtin_bit_cast(bf16x8, (u32x4){x0.x, x0.y, x1.x, x1.y}), b1 = __builtin_bit_cast(bf16x8, (u32x4){x2.x, x2.y, x3.x, x3.y});
            acc = __builtin_amdgcn_mfma_f32_16x16x32_bf16(aV0, b0, acc, 0, 0, 0); acc = __builtin_amdgcn_mfma_f32_16x16x32_bf16(aV1, b1, acc, 0, 0, 0);
        }
        o[ti] = acc;
        float ss = acc[0] * acc[0] + acc[1] * acc[1] + acc[2] * acc[2] + acc[3] * acc[3];
        ss += __shfl_xor(ss, 16); ss += __shfl_xor(ss, 32);
        if (g == 0) ssum[w * 64 + 16 * ti + fr] = ss;
    }
    __syncthreads();
    bf16_t* MIX = (bf16_t*)(p.ws + OFF_MIX);
    const f32x4 ng = *(const f32x4*)(p.hgrn_norm_g + 16 * w + 4 * g);
#pragma unroll
    for (int ti = 0; ti < 4; ++ti) {
        float tot = 0.f;
#pragma unroll
        for (int ww = 0; ww < 8; ++ww) tot += ssum[ww * 64 + 16 * ti + fr];
        const float rstd = rsqrtf(tot * (1.f / 128.f) + RMS_EPS);
        const size_t t = t0 + 16 * ti + fr;
        const uint2 gw = gwv[ti];
        uint2 ow;
        ow.x = pk2(o[ti][0] * rstd * ng[0] * __uint_as_float(gw.x << 16), o[ti][1] * rstd * ng[1] * __uint_as_float(gw.x & 0xffff0000u));
        ow.y = pk2(o[ti][2] * rstd * ng[2] * __uint_as_float(gw.y << 16), o[ti][3] * rstd * ng[3] * __uint_as_float(gw.y & 0xffff0000u));
        *(uint2*)(MIX + t * D_ + h * 128 + 16 * w + 4 * g) = ow;
    }
}

__device__ __forceinline__ int moba_list_off(int j) { return 256 * (63 * j - (j * (j - 1)) / 2); }

__device__ __forceinline__ void moba_kmean(const Params& p, int bid, int nb, LAS unsigned char* lds) {
    const int tid = tidx(), d = tid & 63, kq = tid >> 6;
    const bf16_t* PROJ = (const bf16_t*)(p.ws + OFF_PROJ);
    LAS float* red = (LAS float*)lds;
    float* KM = (float*)(p.ws + OFF_KM);
    for (int u = bid; u < NB_ * AHN * 64; u += nb) {
        const int j = u & 63, h = (u >> 6) & 3, b = u >> 8;
        const bf16_t* kp = PROJ + (size_t)(b * S_ + j * 256 + kq * 32) * NPROJ + C_AK + h * 64 + d;
        float s = 0.f;
#pragma unroll 8
        for (int i = 0; i < 32; ++i) s += bf2f(kp[(size_t)i * NPROJ]);
        __syncthreads();
        red[kq * 64 + d] = s;
        __syncthreads();
        if (tid < 64) { float a = 0.f;
#pragma unroll
            for (int i = 0; i < 8; ++i) a += red[i * 64 + tid];
            KM[u * 64 + tid] = a * (1.f / 256.f); }
    }
}

__device__ __forceinline__ void moba_gating(const Params& p, int bid, int nb, LAS unsigned char* lds, bool dummy = false) {
    const int tid = tidx();
    const bf16_t* PROJ = (const bf16_t*)(p.ws + OFF_PROJ);
    const float* KM = (const float*)(p.ws + OFF_KM);
    LAS float* KML = (LAS float*)lds;
    LAS int* cntl = (LAS int*)(lds + 16384);
    LAS int* basel = cntl + 64;
    unsigned* gcnt = (unsigned*)(p.ws + OFF_CTL) + (dummy ? 1024 : 0);
    int* mlist = (int*)(p.ws + (dummy ? OFF_OP + 101 * MBy : OFF_MLIST));
    for (int item = bid; item < NB_ * AHN * 32; item += nb) {
        const int bh = item >> 5, chunk = item & 31, b = bh >> 2, h = bh & 3;
        __syncthreads();
        for (int i = tid; i < 4096; i += NTHREADS) KML[i] = KM[bh * 4096 + i];
        if (tid < 64) cntl[tid] = 0;
        __syncthreads();
        const int q = chunk * 512 + tid, own = q >> 8;
        const size_t t = (size_t)b * S_ + q;
        float qv[64];
        {
            const u32x4* qp = (const u32x4*)(PROJ + t * NPROJ + C_AQ + h * 64);
#pragma unroll
            for (int c = 0; c < 8; ++c) { const u32x4 wv = qp[c];
                qv[8 * c + 0] = __uint_as_float(wv.x << 16); qv[8 * c + 1] = __uint_as_float(wv.x & 0xffff0000u);
                qv[8 * c + 2] = __uint_as_float(wv.y << 16); qv[8 * c + 3] = __uint_as_float(wv.y & 0xffff0000u);
                qv[8 * c + 4] = __uint_as_float(wv.z << 16); qv[8 * c + 5] = __uint_as_float(wv.z & 0xffff0000u);
                qv[8 * c + 6] = __uint_as_float(wv.w << 16); qv[8 * c + 7] = __uint_as_float(wv.w & 0xffff0000u); }
        }
        float v0 = -INFINITY, v1 = -INFINITY, v2 = -INFINITY; int i0 = 0, i1 = 0, i2 = 0;
        for (int j = 0; j < own; ++j) {
            const LAS f32x4* km = (const LAS f32x4*)(KML + j * 64);
            float gt = 0.f;
#pragma unroll
            for (int c = 0; c < 16; ++c) { const f32x4 kv = km[c]; gt += qv[4 * c] * kv[0] + qv[4 * c + 1] * kv[1] + qv[4 * c + 2] * kv[2] + qv[4 * c + 3] * kv[3]; }
            if (gt > v0) { v2 = v1; i2 = i1; v1 = v0; i1 = i0; v0 = gt; i0 = j; }
            else if (gt > v1) { v2 = v1; i2 = i1; v1 = gt; i1 = j; }
            else if (gt > v2) { v2 = gt; i2 = j; }
        }
        const int nsel = own < 3 ? own : 3;
        int r0 = 0, r1 = 0, r2 = 0;
        if (nsel > 0) r0 = atomicAdd((int*)&cntl[i0], 1);
        if (nsel > 1) r1 = atomicAdd((int*)&cntl[i1], 1);
        if (nsel > 2) r2 = atomicAdd((int*)&cntl[i2], 1);
        __syncthreads();
        if (tid < 64) { const int cc = cntl[tid]; basel[tid] = cc ? (int)atomicAdd(&gcnt[bh * 64 + tid], (unsigned)cc) : 0; }
        __syncthreads();
        int* ml = mlist + (size_t)bh * MLIST_STRIDE;
        if (nsel > 0) ml[moba_list_off(i0) + basel[i0] + r0] = q;
        if (nsel > 1) ml[moba_list_off(i1) + basel[i1] + r1] = q | (1 << 14);
        if (nsel > 2) ml[moba_list_off(i2) + basel[i2] + r2] = q | (2 << 14);
    }
}


__device__ __forceinline__ void phase3b_ws(const Params& p, int bid, int nb, LAS unsigned char* lds) {
    const int tid = tidx(), lane = tid & 63, wave = tid >> 6;
    const bf16_t* PROJ = (const bf16_t*)(p.ws + OFF_PROJ);
    const float* KM = (const float*)(p.ws + OFF_KM);
    LAS float* KML = (LAS float*)lds;
    LAS int* wh = (LAS int*)(lds + 16384) + (wave & 3) * 128;
    unsigned* gcnt = (unsigned*)(p.ws + OFF_CTL);
    int* mlist = (int*)(p.ws + OFF_MLIST);
    bool scan_done = false;
    for (int item = bid; item < NB_ * AHN * 32 || !scan_done; item += nb) {
        const bool has_item = item < NB_ * AHN * 32;
        const int bh = has_item ? item >> 5 : 0, chunk = item & 31, b = bh >> 2, h = bh & 3;
        __syncthreads();
        if (has_item && tid < 256) { for (int i = tid; i < 4096; i += 256) KML[i] = KM[bh * 4096 + i]; }
        __syncthreads();
        if (wave < 4) {
            if (has_item) {
                for (int pass = 0; pass < 2; ++pass) {
                    const int q = chunk * 512 + (wave * 2 + pass) * 64 + lane, own = q >> 8;
                    const size_t t = (size_t)b * S_ + q;
                    float qv[64];
                    {
                        const u32x4* qp = (const u32x4*)(PROJ + t * NPROJ + C_AQ + h * 64);
#pragma unroll
                        for (int c = 0; c < 8; ++c) { const u32x4 wv = qp[c];
                            qv[8 * c + 0] = __uint_as_float(wv.x << 16); qv[8 * c + 1] = __uint_as_float(wv.x & 0xffff0000u);
                            qv[8 * c + 2] = __uint_as_float(wv.y << 16); qv[8 * c + 3] = __uint_as_float(wv.y & 0xffff0000u);
                            qv[8 * c + 4] = __uint_as_float(wv.z << 16); qv[8 * c + 5] = __uint_as_float(wv.z & 0xffff0000u);
                            qv[8 * c + 6] = __uint_as_float(wv.w << 16); qv[8 * c + 7] = __uint_as_float(wv.w & 0xffff0000u); }
                    }
                    float v0 = -INFINITY, v1 = -INFINITY, v2 = -INFINITY; int i0 = 0, i1 = 0, i2 = 0;
                    for (int j = 0; j < own; ++j) {
                        const LAS f32x4* km = (const LAS f32x4*)(KML + j * 64);
                        float gt = 0.f;
#pragma unroll
                        for (int c = 0; c < 16; ++c) { const f32x4 kv = km[c]; gt += qv[4 * c] * kv[0] + qv[4 * c + 1] * kv[1] + qv[4 * c + 2] * kv[2] + qv[4 * c + 3] * kv[3]; }
                        if (gt > v0) { v2 = v1; i2 = i1; v1 = v0; i1 = i0; v0 = gt; i0 = j; }
                        else if (gt > v1) { v2 = v1; i2 = i1; v1 = gt; i1 = j; }
                        else if (gt > v2) { v2 = gt; i2 = j; }
                    }
                    const int nsel = own < 3 ? own : 3;
                    wh[lane] = 0;
                    int r0 = 0, r1 = 0, r2 = 0;
                    if (nsel > 0) r0 = atomicAdd((int*)&wh[i0], 1);
                    if (nsel > 1) r1 = atomicAdd((int*)&wh[i1], 1);
                    if (nsel > 2) r2 = atomicAdd((int*)&wh[i2], 1);
                    const int cc = wh[lane];
                    wh[64 + lane] = cc ? (int)atomicAdd(&gcnt[bh * 64 + lane], (unsigned)cc) : 0;
                    int* ml = mlist + (size_t)bh * MLIST_STRIDE;
                    if (nsel > 0) ml[moba_list_off(i0) + wh[64 + i0] + r0] = q;
                    if (nsel > 1) ml[moba_list_off(i1) + wh[64 + i1] + r1] = q | (1 << 14);
                    if (nsel > 2) ml[moba_list_off(i2) + wh[64 + i2] + r2] = q | (2 << 14);
                }
            }
        } else if (!scan_done) {
            bf16_t* UT = (bf16_t*)(p.ws + OFF_UT);
            const float* DEC = (const float*)(p.ws + OFF_DEC);
            for (int idx = bid * 256 + (tid - 256); idx < NB_ * NHH * 8192; idx += nb * 256) {
                const int bh2 = idx >> 13, r = idx & 8191;
                bf16_t* base = UT + (size_t)bh2 * 256 * 16384 + r * 2;
                const float* db = DEC + (size_t)bh2 * 256 * 128 + (r & 63) * 2;
                float s0 = 0.f, s1 = 0.f;
                for (int c0 = 0; c0 < 256; c0 += 16) {
                    unsigned u[16]; float2 d[16];
#pragma unroll
                    for (int i = 0; i < 16; ++i) { u[i] = *(const unsigned*)(base + (size_t)(c0 + i) * 16384); d[i] = *(const float2*)(db + (c0 + i) * 128); }
#pragma unroll
                    for (int i = 0; i < 16; ++i) {
                        *(unsigned*)(base + (size_t)(c0 + i) * 16384) = pk2(s0, s1);
                        s0 = d[i].x * s0 + __uint_as_float(u[i] << 16); s1 = d[i].y * s1 + __uint_as_float(u[i] & 0xffff0000u);
                    }
                }
            }
        }
        scan_done = true;
    }
    __syncthreads();
}

struct MbDesc { int bh, j, kind, tix; };
struct MbQ { bf16x8 q0, q1; int q, slot, valid; };
__device__ __forceinline__ void moba_q_load(const Params& p, const MbDesc& d, MbQ& rg) {
    const int tid = tidx(), lane = tid & 63, w = tid >> 6, fr = lane & 15, g = lane >> 4;
    const int b = d.bh >> 2, h = d.bh & 3;
    const bf16_t* PROJ = (const bf16_t*)(p.ws + OFF_PROJ);
    if (d.kind == 0) {
        const int cnt = (int)((const unsigned*)(p.ws + OFF_CTL))[d.bh * 64 + d.j], li = d.tix * 128 + 16 * w + fr;
        rg.valid = li < cnt;
        const int entry = ((const int*)(p.ws + OFF_MLIST))[(size_t)d.bh * MLIST_STRIDE + moba_list_off(d.j) + (rg.valid ? li : d.tix * 128)];
        rg.q = entry & 16383; rg.slot = entry >> 14;
    } else { rg.q = 256 * d.j + 128 * d.tix + 16 * w + fr; rg.slot = 3; rg.valid = 1; }
    const bf16_t* qp = PROJ + ((size_t)b * S_ + rg.q) * NPROJ + C_AQ + h * 64;
    rg.q0 = *(const bf16x8*)(qp + 8 * g); rg.q1 = *(const bf16x8*)(qp + 32 + 8 * g);
}
__device__ __forceinline__ void moba_stage_kv(const Params& p, int bh, int j, LAS unsigned char* lds) {
    const int tid = tidx();
    const int b = bh >> 2, h = bh & 3;
    const bf16_t* PROJ = (const bf16_t*)(p.ws + OFF_PROJ);
    LAS bf16_t* KL = (LAS bf16_t*)lds;
    LAS bf16_t* VL = KL + 256 * 72;
    const bf16_t* kvbase = PROJ + (size_t)(b * S_ + j * 256) * NPROJ + h * 64;
    u32x4 kk[4], vv[4];
#pragma unroll
    for (int i = 0; i < 4; ++i) {
        const int id = tid + NTHREADS * i, key = id >> 3, ch = id & 7;
        kk[i] = *(const u32x4*)(kvbase + (size_t)key * NPROJ + C_AK + 8 * ch);
        vv[i] = *(const u32x4*)(kvbase + (size_t)key * NPROJ + C_AV + 8 * ch);
    }
#pragma unroll
    for (int i = 0; i < 4; ++i) {
        const int id = tid + NTHREADS * i, key = id >> 3, ch = id & 7;
        *(LAS u32x4*)(KL + key * 72 + 8 * ch) = kk[i]; *(LAS u32x4*)(VL + key * 72 + 8 * ch) = vv[i];
    }
}
__device__ __forceinline__ void moba_tile(const Params& p, const MbDesc& d, const MbQ& rq, LAS unsigned char* lds) {
    const int tid = tidx(), lane = tid & 63, w = tid >> 6, fr = lane & 15, g = lane >> 4;
    const int b = d.bh >> 2, h = d.bh & 3, kind = d.kind, tix = d.tix;
    LAS bf16_t* KL = (LAS bf16_t*)lds;
    LAS bf16_t* VL = KL + 256 * 72;
    const bf16x8 qf0 = rq.q0, qf1 = rq.q1; const int q = rq.q, slot = rq.slot; const bool valid = rq.valid != 0;
    const size_t t = (size_t)b * S_ + q;
    const int qloc = 128 * tix + 16 * w + fr;
    const int nkt = kind ? (((128 * tix + 16 * w + 15) >> 4) + 1) : 16;
    constexpr float SC = 0.125f * 1.4426950408889634f;
    f32x4 s[16];
#pragma unroll
    for (int kt = 0; kt < 16; ++kt) {
        if (kt < nkt) {
            const bf16x8 a0 = *(const LAS bf16x8*)(KL + (16 * kt + fr) * 72 + 8 * g), a1 = *(const LAS bf16x8*)(KL + (16 * kt + fr) * 72 + 32 + 8 * g);
            f32x4 acc = (f32x4){0.f, 0.f, 0.f, 0.f};
            acc = __builtin_amdgcn_mfma_f32_16x16x32_bf16(a0, qf0, acc, 0, 0, 0);
            acc = __builtin_amdgcn_mfma_f32_16x16x32_bf16(a1, qf1, acc, 0, 0, 0);
            s[kt] = acc;
            if (kind) {
#pragma unroll
                for (int jj = 0; jj < 4; ++jj) if (16 * kt + 4 * g + jj > qloc) s[kt][jj] = -INFINITY;
            }
        } else s[kt] = (f32x4){-INFINITY, -INFINITY, -INFINITY, -INFINITY};
    }
    float m = -INFINITY;
#pragma unroll
    for (int kt = 0; kt < 16; ++kt) m = fmaxf(m, fmaxf(fmaxf(s[kt][0], s[kt][1]), fmaxf(s[kt][2], s[kt][3])));
    m = fmaxf(m, __shfl_xor(m, 16)); m = fmaxf(m, __shfl_xor(m, 32));
    m *= SC;
    float l = 0.f;
#pragma unroll
    for (int kt = 0; kt < 16; ++kt) {
#pragma unroll
        for (int jj = 0; jj < 4; ++jj) { const float e = __builtin_amdgcn_exp2f(__builtin_fmaf(s[kt][jj], SC, -m)); s[kt][jj] = e; l += e; }
    }
    l += __shfl_xor(l, 16); l += __shfl_xor(l, 32);
    bf16x8 pfr[8];
#pragma unroll
    for (int ks = 0; ks < 8; ++ks) {
        u32x4 wv; wv.x = pk2(s[2 * ks][0], s[2 * ks][1]); wv.y = pk2(s[2 * ks][2], s[2 * ks][3]); wv.z = pk2(s[2 * ks + 1][0], s[2 * ks + 1][1]); wv.w = pk2(s[2 * ks + 1][2], s[2 * ks + 1][3]);
        pfr[ks] = __builtin_bit_cast(bf16x8, wv);
    }
    const unsigned vb = (unsigned)(size_t)VL + (unsigned)((4 * g + (fr >> 2)) * 144 + (fr & 3) * 8);
    bf16_t* OP = (bf16_t*)(p.ws + OFF_OP) + ((size_t)slot * T_ + t) * 256 + h * 64;
#pragma unroll
    for (int dt = 0; dt < 4; ++dt) {
        f32x4 acc = (f32x4){0.f, 0.f, 0.f, 0.f};
#pragma unroll
        for (int kh = 0; kh < 2; ++kh) {
            s16x4 lo[4], hi[4];
#pragma unroll
            for (int k4 = 0; k4 < 4; ++k4) {
                asm volatile("ds_read_b64_tr_b16 %0, %1 offset:%2" : "=&v"(lo[k4]) : "v"(vb), "i"((kh * 4 + k4) * 4608 + dt * 32) : "memory");
                asm volatile("ds_read_b64_tr_b16 %0, %1 offset:%2" : "=&v"(hi[k4]) : "v"(vb), "i"((kh * 4 + k4) * 4608 + 2304 + dt * 32) : "memory");
            }
            asm volatile("s_waitcnt lgkmcnt(0)" ::: "memory"); __builtin_amdgcn_sched_barrier(0);
#pragma unroll
            for (int k4 = 0; k4 < 4; ++k4) {
                const int ks = kh * 4 + k4;
                if (2 * ks < nkt) {
                    const bf16x8 va = (bf16x8){lo[k4][0], lo[k4][1], lo[k4][2], lo[k4][3], hi[k4][0], hi[k4][1], hi[k4][2], hi[k4][3]};
                    acc = __builtin_amdgcn_mfma_f32_16x16x32_bf16(va, pfr[ks], acc, 0, 0, 0);
                }
            }
        }
        if (valid) { uint2 ow; ow.x = pk2(acc[0], acc[1]); ow.y = pk2(acc[2], acc[3]); *(uint2*)(OP + 16 * dt + 4 * g) = ow; }
    }
    if (valid && g == 0) {
        ((float*)(p.ws + OFF_LP))[((size_t)slot * T_ + t) * 4 + h] = l;
        ((float*)(p.ws + OFF_MP))[((size_t)slot * T_ + t) * 4 + h] = m;
    }
}

__device__ __forceinline__ void moba_tiles(const Params& p, int bid, int nb, LAS unsigned char* lds) {
    const int tid = tidx();
    LAS int* pf = (LAS int*)(lds + 73728);
    const unsigned* gcnt = (const unsigned*)(p.ws + OFF_CTL);
    __syncthreads();
    { LAS int* sc = pf + 1; sc[tid] = ((int)gcnt[tid] + 127) / 128 + 2; __syncthreads();
      for (int o = 1; o < 512; o <<= 1) { const int a = (tid >= o) ? sc[tid - o] : 0; __syncthreads(); sc[tid] += a; __syncthreads(); }
      if (tid == 0) pf[0] = 0;
      __syncthreads(); }
    const int total = pf[512];
    const int t0 = (int)(((long)total * bid) / nb), t1 = (int)(((long)total * (bid + 1)) / nb);
    if (t0 < t1) {
        int gi; { int lo = 0, hi = 512; while (hi - lo > 1) { const int mid = (lo + hi) >> 1; if (pf[mid] <= t0) lo = mid; else hi = mid; } gi = lo; }
        int local = t0 - pf[gi], gtiles = pf[gi + 1] - pf[gi];
        MbDesc d; d.bh = gi >> 6; d.j = gi & 63; d.kind = local < gtiles - 2 ? 0 : 1; d.tix = local < gtiles - 2 ? local : local - (gtiles - 2);
        MbQ rq; moba_q_load(p, d, rq);
        int staged = -1;
        for (int T = t0; T < t1; ++T) {
            if (gi != staged) { __syncthreads(); moba_stage_kv(p, gi >> 6, gi & 63, lds); __syncthreads(); staged = gi; }
            MbDesc dn = d; MbQ rn = rq; int gin = gi, localn = local + 1, gtn = gtiles;
            if (localn >= gtn) { ++gin; localn = 0; gtn = (gin < 512) ? pf[gin + 1] - pf[gin] : 2; }
            const bool has_next = (T + 1 < t1);
            if (has_next) { dn.bh = gin >> 6; dn.j = gin & 63; dn.kind = localn < gtn - 2 ? 0 : 1; dn.tix = localn < gtn - 2 ? localn : localn - (gtn - 2); moba_q_load(p, dn, rn); }
            moba_tile(p, d, rq, lds);
            d = dn; rq = rn; gi = gin; local = localn; gtiles = gtn;
        }
    }
    __syncthreads();
}

__device__ __forceinline__ void moba_combine(const Params& p, int bid, int nb) {
    const int lane = tidx() & 63, w = tidx() >> 6, h = lane >> 4, d0 = (lane & 15) * 4;
    const bf16_t* OP = (const bf16_t*)(p.ws + OFF_OP);
    const float* LP = (const float*)(p.ws + OFF_LP);
    const float* MP = (const float*)(p.ws + OFF_MP);
    bf16_t* MIX = (bf16_t*)(p.ws + OFF_MIX);
    const f32x4 ng = *(const f32x4*)(p.attn_norm_g + d0);
    for (int t0 = (bid * NWAVES + w) * 4; t0 < T_; t0 += nb * NWAVES * 4) {
        const int own = (t0 & (S_ - 1)) >> 8, nsel = own < 3 ? own : 3;
        float ms[4][4], ls[4][4]; uint2 ov[4][4];
#pragma unroll
        for (int q = 0; q < 4; ++q)
#pragma unroll
            for (int sl = 0; sl < 4; ++sl) {
                const bool on = (sl == 3) || (sl < nsel); const size_t r = (size_t)sl * T_ + t0 + q;
                ms[q][sl] = on ? MP[r * 4 + h] : -INFINITY; ls[q][sl] = on ? LP[r * 4 + h] : 0.f;
                ov[q][sl] = on ? *(const uint2*)(OP + r * 256 + h * 64 + d0) : make_uint2(0u, 0u);
            }
#pragma unroll
        for (int q = 0; q < 4; ++q) {
            const float mx = fmaxf(fmaxf(ms[q][0], ms[q][1]), fmaxf(ms[q][2], ms[q][3]));
            float o0 = 0.f, o1 = 0.f, o2 = 0.f, o3 = 0.f, l = 0.f;
#pragma unroll
            for (int sl = 0; sl < 4; ++sl) {
                const float wg = __builtin_amdgcn_exp2f(ms[q][sl] - mx); l += wg * ls[q][sl];
                o0 += wg * __uint_as_float(ov[q][sl].x << 16); o1 += wg * __uint_as_float(ov[q][sl].x & 0xffff0000u); o2 += wg * __uint_as_float(ov[q][sl].y << 16); o3 += wg * __uint_as_float(ov[q][sl].y & 0xffff0000u);
            }
            const float inv = 1.f / l; o0 *= inv; o1 *= inv; o2 *= inv; o3 *= inv;
            float ss = o0 * o0 + o1 * o1 + o2 * o2 + o3 * o3;
            ss += __shfl_xor(ss, 1); ss += __shfl_xor(ss, 2); ss += __shfl_xor(ss, 4); ss += __shfl_xor(ss, 8);
            const float rstd = rsqrtf(ss * (1.f / 64.f) + RMS_EPS);
            uint2 ow; ow.x = pk2(o0 * rstd * ng[0], o1 * rstd * ng[1]); ow.y = pk2(o2 * rstd * ng[2], o3 * rstd * ng[3]);
            *(uint2*)(MIX + (size_t)(t0 + q) * D_ + HW_ + h * 64 + d0) = ow;
        }
    }
}

__device__ __forceinline__ void phase5(const Params& p, int bid, int nb) {
    const int lane = tidx() & 63, wave = tidx() >> 6, lr = lane & 15, g = lane >> 4;
    const bf16_t* MIX = (const bf16_t*)(p.ws + OFF_MIX);
    const bf16_t* WT = (const bf16_t*)(p.ws + OFF_WOUT);
    const float* mod = (const float*)(p.ws + OFF_MOD);
    constexpr int NMT = T_ / 128, NNT = D_ / 64;
    for (int u = bid; u < NMT * NNT; u += nb) {
        const int mt = u / NNT, nt = u % NNT;
        const int row0 = mt * 128 + wave * 16, col0 = nt * 64;
        const bf16_t* arow = MIX + (size_t)(row0 + lr) * D_;
        const bf16_t* bcol[4];
#pragma unroll
        for (int n = 0; n < 4; ++n) bcol[n] = WT + (size_t)(col0 + 16 * n + lr) * D_;
        f32x4 acc[4];
        wave_gemm<4>(arow, bcol, D_, acc);
        const int b = row0 / S_;
#pragma unroll
        for (int n = 0; n < 4; ++n) {
            const int c = col0 + 16 * n + lr;
            const float g1 = mod[b * NMOD + 2 * D_ + c];
#pragma unroll
            for (int j = 0; j < 4; ++j) {
                const int t = row0 + 4 * g + j;
                p.out[(size_t)t * D_ + c] = p.x[(size_t)t * D_ + c] + g1 * acc[n][j];
            }
        }
    }
}

__device__ __forceinline__ void phase6(const Params& p, int bid, int nb) {
    const int lane = tidx() & 63, wave = tidx() >> 6;
    const float* mod = (const float*)(p.ws + OFF_MOD);
    const float* wrt = (const float*)(p.ws + OFF_WRT);
    bf16_t* H2 = (bf16_t*)(p.ws + OFF_H);
    unsigned* ecnt = (unsigned*)(p.ws + OFF_CTL) + CW_ECNT;
    int* elist = (int*)(p.ws + OFF_ELIST);
    float* gate = (float*)(p.ws + OFF_GATE);
    for (int t = bid * NWAVES + wave; t < T_; t += nb * NWAVES) {
        const int b = t / S_;
        const f32x4* xr = (const f32x4*)(p.out + (size_t)t * D_) + lane;
        f32x4 v[4]; float s = 0.f;
#pragma unroll
        for (int j = 0; j < 4; ++j) { v[j] = xr[64 * j]; s += v[j].x * v[j].x + v[j].y * v[j].y + v[j].z * v[j].z + v[j].w * v[j].w; }
        const float rstd = rsqrtf(wave_sum(s) * (1.f / D_) + RMS_EPS);
        const float* shift = mod + b * NMOD + 3 * D_, *scale = mod + b * NMOD + 4 * D_;
#pragma unroll
        for (int j = 0; j < 4; ++j) {
            const int k = 4 * lane + 256 * j;
            const f32x4 g = *(const f32x4*)(p.norm2_g + k), sc = *(const f32x4*)(scale + k), sh = *(const f32x4*)(shift + k);
            v[j].x = v[j].x * rstd * g.x * (1.f + sc.x) + sh.x; v[j].y = v[j].y * rstd * g.y * (1.f + sc.y) + sh.y;
            v[j].z = v[j].z * rstd * g.z * (1.f + sc.z) + sh.z; v[j].w = v[j].w * rstd * g.w * (1.f + sc.w) + sh.w;
            uint2 w; w.x = pk2(v[j].x, v[j].y); w.y = pk2(v[j].z, v[j].w);
            *(uint2*)(H2 + (size_t)t * D_ + k) = w;
        }
        float bv[4] = {-INFINITY, -INFINITY, -INFINITY, -INFINITY}; int bi[4] = {0, 0, 0, 0};
        for (int e = 0; e < NE_; ++e) {
            float a = 0.f;
#pragma unroll
            for (int j = 0; j < 4; ++j) { const f32x4 w = *(const f32x4*)(wrt + e * 1024 + 4 * lane + 256 * j); a += v[j].x * w.x + v[j].y * w.y + v[j].z * w.z + v[j].w * w.w; }
            a = wave_sum(a) + p.b_router[e];
            if (a > bv[0]) { bv[3] = bv[2]; bi[3] = bi[2]; bv[2] = bv[1]; bi[2] = bi[1]; bv[1] = bv[0]; bi[1] = bi[0]; bv[0] = a; bi[0] = e; }
            else if (a > bv[1]) { bv[3] = bv[2]; bi[3] = bi[2]; bv[2] = bv[1]; bi[2] = bi[1]; bv[1] = a; bi[1] = e; }
            else if (a > bv[2]) { bv[3] = bv[2]; bi[3] = bi[2]; bv[2] = a; bi[2] = e; }
            else if (a > bv[3]) { bv[3] = a; bi[3] = e; }
        }
        if (lane == 0) {
            const float e0 = 1.f, e1 = expf(bv[1] - bv[0]), e2 = expf(bv[2] - bv[0]), e3 = expf(bv[3] - bv[0]);
            const float inv = 1.f / (e0 + e1 + e2 + e3);
            const float gs[4] = {e0 * inv, e1 * inv, e2 * inv, e3 * inv};
#pragma unroll
            for (int k = 0; k < 4; ++k) {
                const unsigned pos = atomicAdd(&ecnt[bi[k]], 1u);
                elist[bi[k] * 32768 + pos] = t * 4 + k;
                gate[t * 4 + k] = gs[k];
            }
        }
    }
}

__device__ __forceinline__ void phase7(const Params& p, int bid, int nb, LAS unsigned char* lds) {
    const int lane = tidx() & 63, wave = tidx() >> 6, lr = lane & 15, g = lane >> 4;
    const bf16_t* H2 = (const bf16_t*)(p.ws + OFF_H);
    const bf16_t* WGU = (const bf16_t*)(p.ws + OFF_WGU);
    bf16_t* ACT = (bf16_t*)(p.ws + OFF_ACT);
    const unsigned* ecnt = (const unsigned*)(p.ws + OFF_CTL) + CW_ECNT;
    const int* elist = (const int*)(p.ws + OFF_ELIST);
    LAS int* pre = (LAS int*)lds;
    if (tidx() == 0) { int a = 0; for (int e = 0; e < NE_; ++e) { pre[e] = a; a += ((int)ecnt[e] + 127) / 128; } pre[NE_] = a; }
    __syncthreads();
    const int total = pre[NE_] * 32;
    for (int u = bid; u < total; u += nb) {
        const int mtg = u / 32, nt = u % 32;
        int e = 0; while (pre[e + 1] <= mtg) ++e;
        const int mt = mtg - pre[e], cnt = (int)ecnt[e];
        const int r = mt * 128 + wave * 16 + lr;
        const int ent = elist[e * 32768 + (r < cnt ? r : 0)];
        const bf16_t* arow = H2 + (size_t)(ent >> 2) * D_;
        const bf16_t* wb = WGU + (size_t)e * 2048 * 1024;
        const bf16_t* bcol[4];
        bcol[0] = wb + (size_t)(nt * 32 + lr) * D_; bcol[1] = wb + (size_t)(nt * 32 + 16 + lr) * D_;
        bcol[2] = wb + (size_t)(1024 + nt * 32 + lr) * D_; bcol[3] = wb + (size_t)(1024 + nt * 32 + 16 + lr) * D_;
        f32x4 acc[4];
        wave_gemm<4>(arow, bcol, D_, acc);
#pragma unroll
        for (int n = 0; n < 2; ++n) {
            const int c = nt * 32 + 16 * n + lr;
            const float bg = p.b_gu[e * 2048 + c], bu = p.b_gu[e * 2048 + 1024 + c];
#pragma unroll
            for (int j = 0; j < 4; ++j) {
                const int rr = mt * 128 + wave * 16 + 4 * g + j;
                if (rr < cnt) {
                    const int en = elist[e * 32768 + rr];
                    const float gv = fminf(acc[n][j] + bg, 7.f);
                    const float uv = fminf(fmaxf(acc[n + 2][j] + bu, -7.f), 7.f);
                    const float a = (uv + 1.f) * gv * sigmoidf_(1.702f * gv);
                    ACT[(size_t)en * DFF_ + c] = f2bf(a);
                }
            }
        }
    }
}

__device__ __forceinline__ void phase8(const Params& p, int bid, int nb, LAS unsigned char* lds) {
    const int lane = tidx() & 63, wave = tidx() >> 6, lr = lane & 15, g = lane >> 4;
    const bf16_t* ACT = (const bf16_t*)(p.ws + OFF_ACT);
    const bf16_t* WDN = (const bf16_t*)(p.ws + OFF_WDN);
    bf16_t* OUT2 = (bf16_t*)(p.ws + OFF_OUT2);
    const unsigned* ecnt = (const unsigned*)(p.ws + OFF_CTL) + CW_ECNT;
    const int* elist = (const int*)(p.ws + OFF_ELIST);
    const float* gate = (const float*)(p.ws + OFF_GATE);
    LAS int* pre = (LAS int*)lds;
    __syncthreads();
    if (tidx() == 0) { int a = 0; for (int e = 0; e < NE_; ++e) { pre[e] = a; a += ((int)ecnt[e] + 127) / 128; } pre[NE_] = a; }
    __syncthreads();
    const int total = pre[NE_] * 16;
    for (int u = bid; u < total; u += nb) {
        const int mtg = u / 16, nt = u % 16;
        int e = 0; while (pre[e + 1] <= mtg) ++e;
        const int mt = mtg - pre[e], cnt = (int)ecnt[e];
        const int r = mt * 128 + wave * 16 + lr;
        const int ent = elist[e * 32768 + (r < cnt ? r : 0)];
        const bf16_t* arow = ACT + (size_t)ent * DFF_;
        const bf16_t* wb = WDN + (size_t)e * 1024 * 1024;
        const bf16_t* bcol[4];
#pragma unroll
        for (int n = 0; n < 4; ++n) bcol[n] = wb + (size_t)(nt * 64 + 16 * n + lr) * DFF_;
        f32x4 acc[4];
        wave_gemm<4>(arow, bcol, DFF_, acc);
#pragma unroll
        for (int n = 0; n < 4; ++n) {
            const int c = nt * 64 + 16 * n + lr;
            const float bd = p.b_dn[e * 1024 + c];
#pragma unroll
            for (int j = 0; j < 4; ++j) {
                const int rr = mt * 128 + wave * 16 + 4 * g + j;
                if (rr < cnt) {
                    const int en = elist[e * 32768 + rr];
                    OUT2[(size_t)en * D_ + c] = f2bf((acc[n][j] + bd) * gate[en]);
                }
            }
        }
    }
}


#define XB_TMO      128
#define XB_XCNT(j)  (256  + 64 * (j))
#define XB_XSUB(j)  (1280 + 64 * (j))
#define XB_XGEN(j)  (2304 + 64 * (j))
#define XB_TOP      3328
#define XB_TOPGEN   3392
#define XCD_BAR_WORDS 3456
#define XB_SPIN_CAP (1u << 18)
__device__ __forceinline__ unsigned xb_ld(unsigned* p)              { return __hip_atomic_load(p, __ATOMIC_RELAXED, __HIP_MEMORY_SCOPE_AGENT); }
__device__ __forceinline__ unsigned xb_add(unsigned* p, unsigned v) { return __hip_atomic_fetch_add(p, v, __ATOMIC_RELAXED, __HIP_MEMORY_SCOPE_AGENT); }
__device__ __forceinline__ unsigned xb_xcc_id() { return (unsigned)__builtin_amdgcn_s_getreg((3 << 11) | 20) & 0xFu; }
#define XB_SPIN(cond, bar) do { unsigned _sp = 0; while (cond) { __builtin_amdgcn_s_sleep(1); \
    if ((++_sp & 255u) == 0u) { if (xb_ld(&(bar)[XB_TMO])) break; if (_sp > XB_SPIN_CAP) { atomicAdd(&(bar)[XB_TMO], 1u); break; } } } } while (0)
struct XcdBarrier { unsigned* bar; unsigned x; volatile LAS unsigned* st; };
__device__ __forceinline__ XcdBarrier xcd_barrier_post(unsigned* bar, volatile LAS unsigned* st) {
    XcdBarrier b; b.bar = bar; b.x = xb_xcc_id(); b.st = st;
    if (tidx() == 0) (void)xb_add(&bar[XB_XCNT(b.x)], 1u);
    return b;
}
__device__ __forceinline__ void xcd_barrier_complete(unsigned* bar, unsigned x, unsigned& nloc, unsigned& nx) {
    const unsigned G = gridDim.x * gridDim.y * gridDim.z;
    unsigned sum, cnt, mine, sp = 0u;
    for (;;) {
        sum = 0u; cnt = 0u; mine = 0u;
#pragma unroll
        for (unsigned j = 0; j < 16; ++j) { const unsigned c = xb_ld(&bar[XB_XCNT(j)]); sum += c; cnt += (c > 0u) ? 1u : 0u; mine = (j == x) ? c : mine; }
        if (sum == G) break;
        __builtin_amdgcn_s_sleep(1);
        if ((++sp & 255u) == 0u) { if (xb_ld(&bar[XB_TMO])) break; if (sp > XB_SPIN_CAP) { atomicAdd(&bar[XB_TMO], 1u); break; } }
    }
    nloc = mine > 0u ? mine : 1u; nx = cnt > 0u ? cnt : 1u;
}
__device__ __forceinline__ void xcd_barrier(const XcdBarrier& b) {
    asm volatile("s_waitcnt vmcnt(0)" ::: "memory");
    __syncthreads();
    if (tidx() == 0) {
        unsigned* bar = b.bar;
        __builtin_amdgcn_s_waitcnt(0);
        unsigned nloc = b.st[0], nx = b.st[1];
        if (nloc == 0u) { xcd_barrier_complete(bar, b.x, nloc, nx); b.st[0] = nloc; b.st[1] = nx; }
        const unsigned old = xb_add(&bar[XB_XSUB(b.x)], 1u);
        const unsigned gen = old / nloc;
        if (old + 1u == (gen + 1u) * nloc) {
            __builtin_amdgcn_fence(__ATOMIC_RELEASE, "agent");
            asm volatile("s_waitcnt vmcnt(0)" ::: "memory");
            const unsigned og = xb_add(&bar[XB_TOP], 1u);
            const unsigned tg = og / nx;
            if (og + 1u == (tg + 1u) * nx) xb_add(&bar[XB_TOPGEN], 1u);
            else XB_SPIN(xb_ld(&bar[XB_TOPGEN]) == tg, bar);
            __builtin_amdgcn_fence(__ATOMIC_ACQUIRE, "agent");
            xb_add(&bar[XB_XGEN(b.x)], 1u);
            asm volatile("s_waitcnt vmcnt(0)" ::: "memory");
        } else {
            XB_SPIN(xb_ld(&bar[XB_XGEN(b.x)]) == gen, bar);
            __builtin_amdgcn_fence(__ATOMIC_ACQUIRE, "agent");
            asm volatile("s_waitcnt vmcnt(0)" ::: "memory");
        }
    }
    __syncthreads();
}

constexpr size_t OFF_MODP = OFF_X + 24 * MBy;
__device__ __forceinline__ void p0_transpose_item(const float* W, int K, int N, bf16_t* WT, LAS float* scr, int item, int lane) {
    const int nblk = N / 32, kb = item / nblk, nbk = item % nblk, k0 = 64 * kb, n0 = 32 * nbk;
    float tv[32];
#pragma unroll
    for (int i = 0; i < 32; ++i) tv[i] = __builtin_nontemporal_load(W + (size_t)(k0 + 2 * i + (lane >> 5)) * N + n0 + (lane & 31));
#pragma unroll
    for (int i = 0; i < 32; ++i) scr[(2 * i + (lane >> 5)) * 33 + (lane & 31)] = tv[i];
    asm volatile("s_waitcnt lgkmcnt(0)" ::: "memory");
    const int c = lane & 7;
#pragma unroll
    for (int j = 0; j < 4; ++j) { const int n = (lane >> 3) + 8 * j; const LAS float* s = scr + (8 * c) * 33 + n;
        u32x4 o; o.x = pk2(s[0 * 33], s[1 * 33]); o.y = pk2(s[2 * 33], s[3 * 33]); o.z = pk2(s[4 * 33], s[5 * 33]); o.w = pk2(s[6 * 33], s[7 * 33]);
        *(u32x4*)(WT + (size_t)(n0 + n) * K + k0 + 8 * c) = o; }
    asm volatile("s_waitcnt lgkmcnt(0)" ::: "memory");
}
__device__ __forceinline__ void p0_transpose_item8(const float* W, int K, int N, unsigned char* WT, LAS float* scr, int item, int lane) {
    const int nblk = N / 32, kb = item / nblk, nbk = item % nblk, k0 = 64 * kb, n0 = 32 * nbk;
    float tv[32];
#pragma unroll
    for (int i = 0; i < 32; ++i) tv[i] = __builtin_nontemporal_load(W + (size_t)(k0 + 2 * i + (lane >> 5)) * N + n0 + (lane & 31));
#pragma unroll
    for (int i = 0; i < 32; ++i) scr[(2 * i + (lane >> 5)) * 33 + (lane & 31)] = tv[i] * W8_SCALE;
    asm volatile("s_waitcnt lgkmcnt(0)" ::: "memory");
    const int c = lane & 7;
#pragma unroll
    for (int j = 0; j < 4; ++j) { const int n = (lane >> 3) + 8 * j; const LAS float* s = scr + (8 * c) * 33 + n;
        uint2 o; o.x = pk4_fp8(s[0 * 33], s[1 * 33], s[2 * 33], s[3 * 33]); o.y = pk4_fp8(s[4 * 33], s[5 * 33], s[6 * 33], s[7 * 33]);
        *(uint2*)(WT + (size_t)(n0 + n) * K + k0 + 8 * c) = o; }
    asm volatile("s_waitcnt lgkmcnt(0)" ::: "memory");
}
__device__ __forceinline__ void phase0_fast(const Params& p, int bid, int nb, LAS unsigned char* lds) {
    const int tid = tidx(), lane = tid & 63, wave = tid >> 6;
    {
        LAS float* sl = (LAS float*)lds;
        LAS float* red = sl + 256;
        float* modp = (float*)(p.ws + OFF_MODP);
        for (int item = bid; item < 24 * 8; item += nb) {
            const int ct = item % 24, ks = item / 24;
            __syncthreads();
            if (tid < 256) { const int bb = tid >> 7, kk = tid & 127; sl[tid] = siluf_(p.c[bb * D_ + ks * 128 + kk]); }
            __syncthreads();
            const int col = ct * 256 + (tid & 255), kh = tid >> 8;
            const float* wp = p.w_ada + (size_t)(ks * 128 + kh * 64) * NMOD + col;
            float a0 = 0.f, a1 = 0.f;
#pragma unroll 16
            for (int k = 0; k < 64; ++k) { const float wv = wp[(size_t)k * NMOD]; a0 += sl[kh * 64 + k] * wv; a1 += sl[128 + kh * 64 + k] * wv; }
            if (kh == 1) { red[tid & 255] = a0; red[256 + (tid & 255)] = a1; }
            __syncthreads();
            if (kh == 0) { modp[(ks * 2 + 0) * NMOD + col] = a0 + red[tid]; modp[(ks * 2 + 1) * NMOD + col] = a1 + red[256 + tid]; }
        }
        __syncthreads();
    }
    float* cs = (float*)(p.ws + OFF_CS);
    for (int i = bid * NTHREADS + tid; i < T_ * 8; i += nb * NTHREADS) {
        const int t = i >> 3, f = i & 7;
        float a = (float)(-13.122363377404328) * (float)(2 * f); a = a / 16.0f;
        const float invf = expf(a);
        const float ang = (float)p.pos[t] * invf;
        cs[t * 16 + f] = cosf(ang); cs[t * 16 + 8 + f] = sinf(ang);
    }
    { float* lbt = (float*)(p.ws + OFF_LB); for (int j = bid * NTHREADS + tid; j < HW_; j += nb * NTHREADS) lbt[j] = 1.f / (1.f + expf(p.lb_logits[HW_ + j] - p.lb_logits[j])); }
    LAS float* scr = (LAS float*)(lds + wave * 8448);
    const int gw = bid * NWAVES + wave, NGW = nb * NWAVES;
    constexpr int I_IN = 16 * (NPROJ / 32), I_OUT = 16 * 32, I_GU = 16 * 64, I_DN = 16 * 32;
    constexpr int NITEMS = I_IN + I_OUT + NE_ * I_GU + NE_ * I_DN;
    for (int it = gw; it < NITEMS; it += NGW) {
        int r = it;
        if (r < I_IN) { if (INPROJ_FP8 && (r % (NPROJ / 32)) < 3072 / 32) p0_transpose_item8(p.w_in, D_, NPROJ, (unsigned char*)(p.ws + OFF_WIN8), scr, r, lane); else p0_transpose_item(p.w_in, D_, NPROJ, (bf16_t*)(p.ws + OFF_WIN), scr, r, lane); continue; } r -= I_IN;
        if (r < I_OUT) { p0_transpose_item(p.w_out, D_, D_, (bf16_t*)(p.ws + OFF_WOUT), scr, r, lane); continue; } r -= I_OUT;
        if (r < NE_ * I_GU) { const int e = r / I_GU;
            if (MOE_FP8) p0_transpose_item8(p.w_gu + (size_t)e * 1024 * 2048, D_, 2048, (unsigned char*)(p.ws + OFF_WGU) + (size_t)e * 2048 * 1024, scr, r % I_GU, lane);
            else p0_transpose_item(p.w_gu + (size_t)e * 1024 * 2048, D_, 2048, (bf16_t*)(p.ws + OFF_WGU) + (size_t)e * 2048 * 1024, scr, r % I_GU, lane); continue; } r -= NE_ * I_GU;
        { const int e = r / I_DN;
            if (MOE_FP8) p0_transpose_item8(p.w_dn + (size_t)e * 1024 * 1024, DFF_, D_, (unsigned char*)(p.ws + OFF_WDN) + (size_t)e * 1024 * 1024, scr, r % I_DN, lane);
            else p0_transpose_item(p.w_dn + (size_t)e * 1024 * 1024, DFF_, D_, (bf16_t*)(p.ws + OFF_WDN) + (size_t)e * 1024 * 1024, scr, r % I_DN, lane); }
    }
}

__device__ __forceinline__ void phase1_fast(const Params& p, int bid, int nb, LAS unsigned char* lds) {
    const int tid = tidx(), lane = tid & 63, wave = tid >> 6;
    const float* modp = (const float*)(p.ws + OFF_MODP);
    float* mod = (float*)(p.ws + OFF_MOD);
    for (int i = bid * NTHREADS + tid; i < 2 * NMOD; i += nb * NTHREADS) {
        const int bb = i / NMOD, j = i % NMOD; float a = p.b_ada[j];
#pragma unroll
        for (int ks = 0; ks < 8; ++ks) a += modp[(ks * 2 + bb) * NMOD + j];
        mod[i] = a;
    }
    LAS float* msh = (LAS float*)lds;
    LAS float* msc = msh + 1024;
    bf16_t* H = (bf16_t*)(p.ws + OFF_H);
    for (int item = bid; item < T_ / 128; item += nb) {
        const int b = (item * 128) / S_;
        __syncthreads();
        for (int i = tid; i < 2048; i += NTHREADS) {
            const int j = i;
            float a = p.b_ada[j];
#pragma unroll
            for (int ks = 0; ks < 8; ++ks) a += modp[(ks * 2 + b) * NMOD + j];
            if (i < 1024) msh[i] = a; else msc[i - 1024] = (1.f + a) * p.norm1_g[i - 1024];
        }
        __syncthreads();
        for (int r0 = wave; r0 < 128; r0 += 4 * NWAVES) {
            f32x4 v[4][4];
#pragma unroll
            for (int q = 0; q < 4; ++q) { const f32x4* xr = (const f32x4*)(p.x + (size_t)(item * 128 + r0 + q * NWAVES) * D_) + lane;
#pragma unroll
                for (int j = 0; j < 4; ++j) v[q][j] = __builtin_nontemporal_load(xr + 64 * j); }
#pragma unroll
            for (int q = 0; q < 4; ++q) {
                const int t = item * 128 + r0 + q * NWAVES;
                float s = 0.f;
#pragma unroll
                for (int j = 0; j < 4; ++j) s += v[q][j].x * v[q][j].x + v[q][j].y * v[q][j].y + v[q][j].z * v[q][j].z + v[q][j].w * v[q][j].w;
                const float rstd = rsqrtf(wave_sum(s) * (1.f / D_) + RMS_EPS);
#pragma unroll
                for (int j = 0; j < 4; ++j) {
                    const int k = 4 * lane + 256 * j;
                    const f32x4 sc = *(const LAS f32x4*)(msc + k), sh = *(const LAS f32x4*)(msh + k);
                    const float h0 = v[q][j].x * rstd * sc.x + sh.x, h1 = v[q][j].y * rstd * sc.y + sh.y, h2v = v[q][j].z * rstd * sc.z + sh.z, h3 = v[q][j].w * rstd * sc.w + sh.w;
                    uint2 w; w.x = pk2(h0, h1); w.y = pk2(h2v, h3);
                    *(uint2*)(H + (size_t)t * D_ + k) = w;
                    if (INPROJ_FP8) *(unsigned*)((unsigned char*)(p.ws + OFF_H8) + (size_t)t * D_ + k) = pk4_fp8(fminf(fmaxf(h0, -448.f), 448.f), fminf(fmaxf(h1, -448.f), 448.f), fminf(fmaxf(h2v, -448.f), 448.f), fminf(fmaxf(h3, -448.f), 448.f));
                }
            }
        }
    }
}

__device__ __forceinline__ void phase6_fast(const Params& p, int bid, int nb, LAS unsigned char* lds, bool dummy = false) {
    const int tid = tidx(), lane = tid & 63, w = tid >> 6, fr = lane & 15, g = lane >> 4;
    const float* mod = (const float*)(p.ws + OFF_MOD);
    LAS bf16_t* WH = (LAS bf16_t*)lds;
    LAS bf16_t* WL = WH + 32 * 1032;
    LAS float* LG = (LAS float*)(WL + 32 * 1032);
    LAS float* biasl = LG + 128 * 33;
    LAS float* rstdl = biasl + 32;
    LAS int* cntl = (LAS int*)(rstdl + 128);
    LAS int* basel = cntl + 32;
    LAS float* red = (LAS float*)(basel + 32);
    bf16_t* H2 = (bf16_t*)(p.ws + OFF_H);
    const bf16_t* X1B = (const bf16_t*)(p.ws + OFF_X1B);
    unsigned* ecnt = (unsigned*)(p.ws + OFF_CTL) + (dummy ? 640 : CW_ECNT);
    int* elist = (int*)(p.ws + (dummy ? OFF_U : OFF_ELIST));
    float* gate = (float*)(p.ws + (dummy ? OFF_U + 8 * MBy : OFF_GATE));
    int cur_b = -1;
    for (int item = bid; item < T_ / 128; item += nb) {
        const int b = (item * 128) / S_;
        const float* sh2 = mod + b * NMOD + 3 * D_, *sc2 = mod + b * NMOD + 4 * D_;
        __syncthreads();
        if (b != cur_b) {
            cur_b = b;
            float bp = 0.f;
            for (int idx = tid; idx < 32768; idx += NTHREADS) {
                const int k = idx >> 5, e = idx & 31;
                const float wv = p.w_router[idx];
                const float val = wv * p.norm2_g[k] * (1.f + sc2[k]);
                const bf16_t hi = f2bf(val); const bf16_t lo = f2bf(val - bf2f(hi));
                WH[e * 1032 + k] = hi; WL[e * 1032 + k] = lo;
                bp += sh2[k] * wv;
            }
            red[(tid >> 5) * 32 + (tid & 31)] = bp;
            __syncthreads();
            if (tid < 32) { float a = p.b_router[tid];
#pragma unroll
                for (int i = 0; i < 16; ++i) a += red[i * 32 + tid];
                biasl[tid] = a; }
        }
        if (tid < 32) cntl[tid] = 0;
        __syncthreads();
        {
            const int t = item * 128 + 16 * w + fr;
            const bf16_t* xr = X1B + (size_t)t * D_ + 8 * g;
            f32x4 acc0 = (f32x4){0.f, 0.f, 0.f, 0.f}, acc1 = (f32x4){0.f, 0.f, 0.f, 0.f};
            float ssq = 0.f;
            const LAS bf16_t* wh0 = WH + fr * 1032 + 8 * g; const LAS bf16_t* wl0 = WL + fr * 1032 + 8 * g;
#pragma unroll 8
            for (int ks = 0; ks < 32; ++ks) {
                const u32x4 xw = *(const u32x4*)(xr + 32 * ks);
                const bf16x8 a = __builtin_bit_cast(bf16x8, xw);
#pragma unroll
                for (int c = 0; c < 4; ++c) { const float lo = __uint_as_float(xw[c] << 16), hi = __uint_as_float(xw[c] & 0xffff0000u); ssq += lo * lo + hi * hi; }
                const bf16x8 bh0 = *(const LAS bf16x8*)(wh0 + 32 * ks), bl0 = *(const LAS bf16x8*)(wl0 + 32 * ks);
                const bf16x8 bh1 = *(const LAS bf16x8*)(wh0 + 16 * 1032 + 32 * ks), bl1 = *(const LAS bf16x8*)(wl0 + 16 * 1032 + 32 * ks);
                acc0 = __builtin_amdgcn_mfma_f32_16x16x32_bf16(a, bh0, acc0, 0, 0, 0); acc1 = __builtin_amdgcn_mfma_f32_16x16x32_bf16(a, bh1, acc1, 0, 0, 0);
                acc0 = __builtin_amdgcn_mfma_f32_16x16x32_bf16(a, bl0, acc0, 0, 0, 0); acc1 = __builtin_amdgcn_mfma_f32_16x16x32_bf16(a, bl1, acc1, 0, 0, 0);
            }
            ssq += __shfl_xor(ssq, 16); ssq += __shfl_xor(ssq, 32);
            if (g == 0) rstdl[16 * w + fr] = rsqrtf(ssq * (1.f / D_) + RMS_EPS);
            __syncthreads();
#pragma unroll
            for (int j = 0; j < 4; ++j) {
                const int tl = 16 * w + 4 * g + j; const float rs = rstdl[tl];
                LG[tl * 33 + fr] = acc0[j] * rs + biasl[fr];
                LG[tl * 33 + 16 + fr] = acc1[j] * rs + biasl[16 + fr];
            }
        }
        __syncthreads();
        int bi[4] = {0, 0, 0, 0}; float gs[4] = {0.f, 0.f, 0.f, 0.f}; int rk[4] = {0, 0, 0, 0};
        if (tid < 128) {
            float bv[4] = {-INFINITY, -INFINITY, -INFINITY, -INFINITY};
            for (int e = 0; e < NE_; ++e) {
                const float a = LG[tid * 33 + e];
                if (a > bv[0]) { bv[3] = bv[2]; bi[3] = bi[2]; bv[2] = bv[1]; bi[2] = bi[1]; bv[1] = bv[0]; bi[1] = bi[0]; bv[0] = a; bi[0] = e; }
                else if (a > bv[1]) { bv[3] = bv[2]; bi[3] = bi[2]; bv[2] = bv[1]; bi[2] = bi[1]; bv[1] = a; bi[1] = e; }
                else if (a > bv[2]) { bv[3] = bv[2]; bi[3] = bi[2]; bv[2] = a; bi[2] = e; }
                else if (a > bv[3]) { bv[3] = a; bi[3] = e; }
            }
            const float e1 = expf(bv[1] - bv[0]), e2 = expf(bv[2] - bv[0]), e3 = expf(bv[3] - bv[0]);
            const float inv = 1.f / (1.f + e1 + e2 + e3);
            gs[0] = inv; gs[1] = e1 * inv; gs[2] = e2 * inv; gs[3] = e3 * inv;
#pragma unroll
            for (int k = 0; k < 4; ++k) rk[k] = atomicAdd((int*)&cntl[bi[k]], 1);
        }
        __syncthreads();
        if (tid < 32) { const int cc = cntl[tid]; basel[tid] = cc ? (int)atomicAdd(&ecnt[tid], (unsigned)cc) : 0; }
        __syncthreads();
        if (tid < 128) {
            const int t = item * 128 + tid;
#pragma unroll
            for (int k = 0; k < 4; ++k) { elist[bi[k] * 32768 + basel[bi[k]] + rk[k]] = t * 4 + k; gate[t * 4 + k] = gs[k]; }
        }
        {
            f32x4 gsc[4], gsh[4];
#pragma unroll
            for (int j = 0; j < 4; ++j) { const int k = 4 * lane + 256 * j; const f32x4 gg = *(const f32x4*)(p.norm2_g + k), sc = *(const f32x4*)(sc2 + k); gsh[j] = *(const f32x4*)(sh2 + k);
                gsc[j] = (f32x4){gg[0] * (1.f + sc[0]), gg[1] * (1.f + sc[1]), gg[2] * (1.f + sc[2]), gg[3] * (1.f + sc[3])}; }
            for (int r0 = 0; r0 < 16; r0 += 4) {
                uint2 xw[4][4];
#pragma unroll
                for (int q = 0; q < 4; ++q) { const uint2* xr = (const uint2*)(X1B + (size_t)(item * 128 + 16 * w + r0 + q) * D_) + lane;
#pragma unroll
                    for (int j = 0; j < 4; ++j) xw[q][j] = xr[64 * j]; }
#pragma unroll
                for (int q = 0; q < 4; ++q) {
                    const int t = item * 128 + 16 * w + r0 + q; const float rs = rstdl[16 * w + r0 + q];
#pragma unroll
                    for (int j = 0; j < 4; ++j) {
                        const f32x4 v = (f32x4){__uint_as_float(xw[q][j].x << 16), __uint_as_float(xw[q][j].x & 0xffff0000u), __uint_as_float(xw[q][j].y << 16), __uint_as_float(xw[q][j].y & 0xffff0000u)};
                        const float h0 = v[0] * rs * gsc[j][0] + gsh[j][0], h1 = v[1] * rs * gsc[j][1] + gsh[j][1], h2v = v[2] * rs * gsc[j][2] + gsh[j][2], h3 = v[3] * rs * gsc[j][3] + gsh[j][3];
                        if (MOE_FP8) { *(unsigned*)((unsigned char*)H2 + (size_t)t * D_ + 4 * lane + 256 * j) = pk4_fp8(fminf(fmaxf(h0, -448.f), 448.f), fminf(fmaxf(h1, -448.f), 448.f), fminf(fmaxf(h2v, -448.f), 448.f), fminf(fmaxf(h3, -448.f), 448.f)); }
                        else { uint2 o; o.x = pk2(h0, h1); o.y = pk2(h2v, h3); *(uint2*)(H2 + (size_t)t * D_ + 4 * lane + 256 * j) = o; }
                    }
                }
            }
        }
    }
    __syncthreads();
}

__device__ __forceinline__ void phase9(const Params& p, int bid, int nb) {
    const int lane = tidx() & 63, wave = tidx() >> 6;
    const float* mod = (const float*)(p.ws + OFF_MOD);
    const bf16_t* OUT2 = (const bf16_t*)(p.ws + OFF_OUT2);
    for (int t = bid * NWAVES + wave; t < T_; t += nb * NWAVES) {
        const int b = t / S_;
        f32x4* xr = (f32x4*)(p.out + (size_t)t * D_) + lane;
        const float* g2 = mod + b * NMOD + 5 * D_;
        f32x4 v[4]; float s = 0.f;
#pragma unroll
        for (int j = 0; j < 4; ++j) {
            const int k = 4 * lane + 256 * j;
            v[j] = xr[64 * j];
            f32x4 y = (f32x4){0.f, 0.f, 0.f, 0.f};
#pragma unroll
            for (int kk = 0; kk < 4; ++kk) { const uint2 w = *(const uint2*)(OUT2 + (size_t)(t * 4 + kk) * D_ + k);
                y.x += __uint_as_float(w.x << 16); y.y += __uint_as_float(w.x & 0xffff0000u); y.z += __uint_as_float(w.y << 16); y.w += __uint_as_float(w.y & 0xffff0000u); }
            const f32x4 gg = *(const f32x4*)(g2 + k);
            v[j].x += gg.x * y.x; v[j].y += gg.y * y.y; v[j].z += gg.z * y.z; v[j].w += gg.w * y.w;
            s += v[j].x * v[j].x + v[j].y * v[j].y + v[j].z * v[j].z + v[j].w * v[j].w;
        }
        const float rstd = rsqrtf(wave_sum(s) * (1.f / D_) + RMS_EPS);
#pragma unroll
        for (int j = 0; j < 4; ++j) {
            const f32x4 fg = *(const f32x4*)(p.final_g + 4 * lane + 256 * j);
            f32x4 o; o.x = v[j].x * rstd * fg.x; o.y = v[j].y * rstd * fg.y; o.z = v[j].z * rstd * fg.z; o.w = v[j].w * rstd * fg.w;
            xr[64 * j] = o;
        }
    }
}


__device__ __forceinline__ void phase9_fast(const Params& p, int bid, int nb) {
    const int lane = tidx() & 63, wave = tidx() >> 6;
    const float* mod = (const float*)(p.ws + OFF_MOD);
    const unsigned char* OUT2 = (const unsigned char*)(p.ws + OFF_OUT2);
    const bf16_t* X1B = (const bf16_t*)(p.ws + OFF_X1B);
    typedef float f32x2 __attribute__((ext_vector_type(2)));
    f32x4 fgv[4];
#pragma unroll
    for (int j = 0; j < 4; ++j) fgv[j] = *(const f32x4*)(p.final_g + 4 * lane + 256 * j);
    for (int t0 = (bid * NWAVES + wave) * 4; t0 < T_; t0 += nb * NWAVES * 4) {
        const int b = t0 / S_;
        const float* g2 = mod + b * NMOD + 5 * D_;
        uint2 xw[4][4]; int ow[4][4][4]; f32x4 gtv[4];
#pragma unroll
        for (int q = 0; q < 4; ++q) gtv[q] = *(const f32x4*)((const float*)(p.ws + OFF_GATE) + (size_t)(t0 + q) * 4);
#pragma unroll
        for (int q = 0; q < 4; ++q)
#pragma unroll
            for (int j = 0; j < 4; ++j) {
                const int k = 4 * lane + 256 * j; const int t = t0 + q;
                xw[q][j] = *(const uint2*)(X1B + (size_t)t * D_ + k);
#pragma unroll
                for (int kk = 0; kk < 4; ++kk) ow[q][j][kk] = *(const int*)(OUT2 + (size_t)(t * 4 + kk) * D_ + k);
            }
#pragma unroll
        for (int q = 0; q < 4; ++q) {
            __builtin_amdgcn_sched_barrier(0);
            const int t = t0 + q;
            f32x4 v[4]; float s = 0.f;
#pragma unroll
            for (int j = 0; j < 4; ++j) {
                const int k = 4 * lane + 256 * j;
                f32x4 y = (f32x4){0.f, 0.f, 0.f, 0.f};
#pragma unroll
                for (int kk = 0; kk < 4; ++kk) { const f32x2 lo = __builtin_amdgcn_cvt_pk_f32_fp8(ow[q][j][kk], false), hi = __builtin_amdgcn_cvt_pk_f32_fp8(ow[q][j][kk], true);
                    const float gk = gtv[q][kk]; y[0] += gk * lo[0]; y[1] += gk * lo[1]; y[2] += gk * hi[0]; y[3] += gk * hi[1]; }
                const f32x4 gg = *(const f32x4*)(g2 + k);
                v[j][0] = __uint_as_float(xw[q][j].x << 16) + gg[0] * y[0] * OUT2_INV; v[j][1] = __uint_as_float(xw[q][j].x & 0xffff0000u) + gg[1] * y[1] * OUT2_INV;
                v[j][2] = __uint_as_float(xw[q][j].y << 16) + gg[2] * y[2] * OUT2_INV; v[j][3] = __uint_as_float(xw[q][j].y & 0xffff0000u) + gg[3] * y[3] * OUT2_INV;
                s += v[j][0] * v[j][0] + v[j][1] * v[j][1] + v[j][2] * v[j][2] + v[j][3] * v[j][3];
            }
            const float rstd = rsqrtf(wave_sum(s) * (1.f / D_) + RMS_EPS);
            f32x4* orow = (f32x4*)(p.out + (size_t)t * D_) + lane;
#pragma unroll
            for (int j = 0; j < 4; ++j) orow[64 * j] = (f32x4){v[j][0] * rstd * fgv[j][0], v[j][1] * rstd * fgv[j][1], v[j][2] * rstd * fgv[j][2], v[j][3] * rstd * fgv[j][3]};
        }
    }
}

constexpr int LDS_BYTES = 163840;

template <int PH>
__device__ __forceinline__ void run_phase(const Params& p, int bid, int nb, LAS unsigned char* lds) {
    if (PH == 0) { if (FAST0) phase0_fast(p, bid, nb, lds); else phase0(p, bid, nb, lds); }
    if (PH == 1) { if (FAST0) phase1_fast(p, bid, nb, lds); else phase1(p, bid, nb); }
    if (PH == 2) { if (FAST2) phase2_fast(p, bid, nb, lds); else phase2(p, bid, nb); }
    if (PH == 3) { phase3(p, bid, nb); if (HG_FAST) { HgRegs<2> rg; if (bid < NB_ * NHH * 256) hgrn_local_load(p, bid, rg); for (int u = bid; u < NB_ * NHH * 256; u += nb) hgrn_local_unit2(p, u, (u + nb < NB_ * NHH * 256) ? u + nb : -1, rg, lds); __syncthreads(); } if (MB_FAST) moba_kmean(p, bid, nb, lds); }
    if (PH == 10) { if (P3B_WS) phase3b_ws(p, bid, nb, lds); else { if (HG_FAST) hgrn_scan(p, bid, nb); if (MB_FAST) moba_gating(p, bid, nb, lds); } }
    if (PH == 4) { phase4(p, bid, nb); for (int rep = 0; rep < 1 + (PROBE4 & 1); ++rep) { HgOutRegs rg; if (bid < NB_ * NHH * 256) hgrn_out_load(p, bid, rg); for (int u = bid; u < NB_ * NHH * 256; u += nb) hgrn_out_unit2(p, u, (u + nb < NB_ * NHH * 256) ? u + nb : -1, rg, lds); __syncthreads(); } for (int rep = 0; rep < 1 + ((PROBE4 >> 1) & 1); ++rep) moba_tiles(p, bid, nb, lds); }
    if (PH == 11) { if (MB_FAST) moba_combine(p, bid, nb); }
    if (PH == 5) { if (FAST5) phase5_fast(p, bid, nb, lds); else phase5(p, bid, nb); }
    if (PH == 6) { if (PROBEX & 4) phase6_fast(p, bid, nb, lds, true); if (FAST6) phase6_fast(p, bid, nb, lds); else phase6(p, bid, nb); }
    if (PH == 7) { if (MOE_FP8) phase_moe_fast8<1>(p, bid, nb, lds); else phase7(p, bid, nb, lds); }
    if (PH == 8) { if (MOE_FP8) phase_moe_fast8<2>(p, bid, nb, lds); else phase8(p, bid, nb, lds); }
    if (PH == 9) { if (PROBEX & 8) phase9_fast(p, bid, nb); phase9_fast(p, bid, nb); }
}

template <int PH>
__global__ void __launch_bounds__(NTHREADS, 2) k_phase(Params p) {
    extern __shared__ __attribute__((aligned(16))) unsigned char lds_raw[];
    run_phase<PH>(p, blockIdx.x, gridDim.x, (LAS unsigned char*)lds_raw);
}

__global__ void __launch_bounds__(NTHREADS, 2) k_mega(Params p) {
    extern __shared__ __attribute__((aligned(16))) unsigned char lds_raw[];
    LAS unsigned char* lds = (LAS unsigned char*)lds_raw;
    cg::grid_group grid = cg::this_grid();
    const int bid = blockIdx.x, nb = gridDim.x;
    volatile LAS unsigned* xbw = (volatile LAS unsigned*)(lds + LDS_BYTES - 16);
    if (tidx() == 0) { xbw[0] = 0u; xbw[1] = 0u; }
    __syncthreads();
    (void)xcd_barrier_post((unsigned*)(p.ws + OFF_CTL) + CW_BAR, xbw);
#define GSYNC() do { if (XBAR) { XcdBarrier _xb; _xb.bar = (unsigned*)(p.ws + OFF_CTL) + CW_BAR; _xb.x = xb_xcc_id(); _xb.st = (volatile LAS unsigned*)(lds + LDS_BYTES - 16); xcd_barrier(_xb); } else grid.sync(); } while (0)
#define RUNP(PH) do { run_phase<PH>(p, bid, nb, lds); GSYNC(); if ((PROBE_DUP >> PH) & 1) { run_phase<PH>(p, bid, nb, lds); GSYNC(); } } while (0)
    run_phase<0>(p, bid, nb, lds); grid.sync();
    if (PROBE_DUP & 1) { run_phase<0>(p, bid, nb, lds); GSYNC(); } RUNP(1); RUNP(2); RUNP(3); RUNP(10); RUNP(4); RUNP(11); RUNP(5); RUNP(6); RUNP(7); RUNP(8);
    run_phase<9>(p, bid, nb, lds);
}

extern "C" void kernel_launch(void* const* d_in, const int* in_sizes, int n_in, void* d_out, int out_size, void* d_ws, size_t ws_size, hipStream_t stream) {
    static int grid = 0;
    if (grid == 0) {
        if (n_in != 19 || ws_size < WS_END) { fprintf(stderr, "kernel_launch: unexpected n_in %d or ws_size %zu (< %zu)\n", n_in, ws_size, (size_t)WS_END); grid = -1; return; }
        int dev = 0, cus = 0, per_cu = 0;
        (void)hipGetDevice(&dev); (void)hipDeviceGetAttribute(&cus, hipDeviceAttributeMultiprocessorCount, dev);
        if (hipFuncSetAttribute((const void*)k_mega, hipFuncAttributeMaxDynamicSharedMemorySize, LDS_BYTES) != hipSuccess) { fprintf(stderr, "hipFuncSetAttribute failed\n"); }
        (void)hipOccupancyMaxActiveBlocksPerMultiprocessor(&per_cu, (const void*)k_mega, NTHREADS, LDS_BYTES);
        if (per_cu < 1) { fprintf(stderr, "kernel_launch: occupancy query says %d blocks per CU\n", per_cu); per_cu = 1; }
        grid = cus;
        (void)hipGetLastError();
    }
    if (grid < 0) return;
    Params p{};
    p.x = (const float*)d_in[0]; p.c = (const float*)d_in[1]; p.pos = (const int*)d_in[2];
    p.w_ada = (const float*)d_in[3]; p.b_ada = (const float*)d_in[4]; p.norm1_g = (const float*)d_in[5]; p.w_in = (const float*)d_in[6];
    p.lb_logits = (const float*)d_in[7]; p.hgrn_norm_g = (const float*)d_in[8]; p.attn_norm_g = (const float*)d_in[9]; p.w_out = (const float*)d_in[10];
    p.norm2_g = (const float*)d_in[11]; p.w_router = (const float*)d_in[12]; p.b_router = (const float*)d_in[13]; p.w_gu = (const float*)d_in[14];
    p.b_gu = (const float*)d_in[15]; p.w_dn = (const float*)d_in[16]; p.b_dn = (const float*)d_in[17]; p.final_g = (const float*)d_in[18];
    p.out = (float*)d_out; p.ws = (unsigned char*)d_ws;
    (void)hipMemsetAsync((char*)d_ws + OFF_CTL, 0, 64 * KB, stream);
#if MEGA
    void* args[] = {&p};
    hipError_t e = hipLaunchCooperativeKernel((const void*)k_mega, dim3(grid), dim3(NTHREADS), args, LDS_BYTES, stream);
    if (e != hipSuccess) fprintf(stderr, "cooperative launch failed: %s (grid %d)\n", hipGetErrorString(e), grid);
#else
    const int G = grid * 2;
    hipLaunchKernelGGL(k_phase<0>, dim3(G), dim3(NTHREADS), LDS_BYTES, stream, p);
    hipLaunchKernelGGL(k_phase<1>, dim3(G), dim3(NTHREADS), LDS_BYTES, stream, p);
    hipLaunchKernelGGL(k_phase<2>, dim3(G), dim3(NTHREADS), LDS_BYTES, stream, p);
    hipLaunchKernelGGL(k_phase<3>, dim3(G), dim3(NTHREADS), LDS_BYTES, stream, p);
    hipLaunchKernelGGL(k_phase<10>, dim3(G), dim3(NTHREADS), LDS_BYTES, stream, p);
    hipLaunchKernelGGL(k_phase<4>, dim3(G), dim3(NTHREADS), LDS_BYTES, stream, p);
    hipLaunchKernelGGL(k_phase<11>, dim3(G), dim3(NTHREADS), LDS_BYTES, stream, p);
    hipLaunchKernelGGL(k_phase<5>, dim3(G), dim3(NTHREADS), LDS_BYTES, stream, p);
    hipLaunchKernelGGL(k_phase<6>, dim3(G), dim3(NTHREADS), LDS_BYTES, stream, p);
    hipLaunchKernelGGL(k_phase<7>, dim3(G), dim3(NTHREADS), LDS_BYTES, stream, p);
    hipLaunchKernelGGL(k_phase<8>, dim3(G), dim3(NTHREADS), LDS_BYTES, stream, p);
    hipLaunchKernelGGL(k_phase<9>, dim3(G), dim3(NTHREADS), LDS_BYTES, stream, p);
#endif
}
```
